# Optimizing an MI355X kernel written in HIP

```python
import jax, jax.numpy as jnp
from jax import lax
import numpy as np

D_MODEL = 1024
BATCH = 4
SEQ = 4096
DEPTH = 2

EXPAND = 2
D_INNER = EXPAND * D_MODEL
BLOCK = 128
A_WIDTH = D_INNER // 2
A_GROUPS = 8
A_GROUP_DIM = A_WIDTH // A_GROUPS
B_HEADS = 8
B_HEAD_DIM = (D_INNER - A_WIDTH) // B_HEADS
B_WIDTH = B_HEADS * B_HEAD_DIM
C_WIDTH = D_INNER // 2
POOL_WINDOWS = (2, 4, 8, 16)
C_GROUPS = len(POOL_WINDOWS)
C_GROUP_DIM = C_WIDTH // C_GROUPS
D_HEADS = 8
D_HEAD_DIM = (D_INNER - C_WIDTH) // D_HEADS
D_WIDTH = D_HEADS * D_HEAD_DIM
ROPE_BASE = 10000.0
EPS = 1e-6

EVEN_SPLITS = (A_WIDTH, 2 * A_WIDTH, 2 * A_WIDTH + B_WIDTH, 2 * A_WIDTH + 2 * B_WIDTH, 2 * A_WIDTH + 3 * B_WIDTH)
ODD_SPLITS = (C_WIDTH, C_WIDTH + D_WIDTH, C_WIDTH + 2 * D_WIDTH, C_WIDTH + 3 * D_WIDTH)
EVEN_IN = EVEN_SPLITS[-1] + D_INNER
ODD_IN = ODD_SPLITS[-1] + D_INNER

kernel_name = "hybrid_gmlp_stickbreak_pool_retention_adaln"


def rms_norm(x, g):
    xf = x.astype(jnp.float32)
    y = xf * lax.rsqrt(jnp.mean(xf * xf, axis=-1, keepdims=True) + EPS)
    return (y * g.astype(jnp.float32)).astype(x.dtype)


def ada_modulation(c, w_mod, b_mod):
    m = jax.nn.silu(c) @ w_mod + b_mod
    shift, scale, gate = jnp.split(m, 3, axis=-1)
    return shift[:, None], scale[:, None], gate[:, None]


def to_heads(t, h, dh):
    b, s, _ = t.shape
    return t.reshape(b, s, h, dh).transpose(0, 2, 1, 3)


def from_heads(t):
    b, h, s, dh = t.shape
    return t.transpose(0, 2, 1, 3).reshape(b, s, h * dh)


def rotary(t, positions):
    half = t.shape[-1] // 2
    inv_freq = ROPE_BASE ** (-jnp.arange(half, dtype=jnp.float32) / half)
    ang = positions.astype(jnp.float32)[:, None, :, None] * inv_freq
    cos, sin = jnp.cos(ang), jnp.sin(ang)
    t1, t2 = t[..., :half].astype(jnp.float32), t[..., half:].astype(jnp.float32)
    out = jnp.concatenate([t1 * cos - t2 * sin, t1 * sin + t2 * cos], axis=-1)
    return out.astype(t.dtype)


def chunked_spatial_gating(u, v, v_norm_g, w_s, b_s):
    b, s, _ = u.shape
    nc = s // BLOCK
    vg = rms_norm(v.reshape(b, nc, BLOCK, A_GROUPS, A_GROUP_DIM), v_norm_g)
    causal = jnp.tril(jnp.ones((BLOCK, BLOCK), dtype=bool))
    w = jnp.where(causal[None], w_s, 0.0)
    mixed = jnp.einsum('gts,bnsgc->bntgc', w, vg) + b_s.T[:, :, None]
    return u * mixed.reshape(b, s, A_WIDTH)


def stick_breaking_attention(q, k, v):
    b, h, s, dh = q.shape
    nb = s // BLOCK
    scale = dh ** -0.5
    key_pos = jnp.arange(s)
    q_blocks = q.reshape(b, h, nb, BLOCK, dh).transpose(2, 0, 1, 3, 4)

    def one_block(args):
        q_blk, start = args
        z = jnp.einsum('bhtd,bhsd->bhts', q_blk, k).astype(jnp.float32) * scale
        q_pos = start + jnp.arange(BLOCK)
        before = key_pos[None, :] < q_pos[:, None]
        log_1m = jnp.where(before, jax.nn.log_sigmoid(-z), 0.0)
        between = lax.cumsum(log_1m, axis=3, reverse=True) - log_1m
        w = jnp.where(before, jnp.exp(jax.nn.log_sigmoid(z) + between), 0.0)
        return jnp.einsum('bhts,bhsd->bhtd', w.astype(v.dtype), v)

    starts = jnp.arange(nb, dtype=jnp.int32) * BLOCK
    out = lax.map(one_block, (q_blocks, starts))
    return out.transpose(1, 2, 0, 3, 4).reshape(b, h, s, dh)


def multiscale_pool(x, w_group, scale):
    b, s, _ = x.shape
    xg = x.reshape(b, s, C_GROUPS, C_GROUP_DIM)
    cs = jnp.cumsum(xg.astype(jnp.float32), axis=1)
    t = jnp.arange(s)
    pooled = []
    for gi, win in enumerate(POOL_WINDOWS):
        cg = cs[:, :, gi]
        lagged = jnp.pad(cg, ((0, 0), (win, 0), (0, 0)))[:, :s]
        count = jnp.minimum(t + 1, win).astype(jnp.float32)[None, :, None]
        pooled.append((cg - lagged) / count)
    pooled = (jnp.stack(pooled, axis=2) - xg.astype(jnp.float32)).astype(x.dtype)
    mixed = jnp.einsum('bsgc,gce->bsge', pooled, w_group)
    return mixed.reshape(b, s, C_WIDTH) * scale


def retention_chunkwise(q, k, v):
    b, h, s, dh = q.shape
    nc = s // BLOCK
    f32 = jnp.float32
    log_gamma = jnp.log1p(-jnp.exp2(-5.0 - jnp.arange(h, dtype=f32)))
    idx = jnp.arange(BLOCK, dtype=f32)
    diff = idx[:, None] - idx[None, :]
    intra_decay = jnp.where(diff >= 0, jnp.exp(log_gamma[:, None, None] * jnp.maximum(diff, 0.0)), 0.0)
    q_decay = jnp.exp(log_gamma[:, None] * (idx + 1.0))
    k_decay = jnp.exp(log_gamma[:, None] * (BLOCK - 1.0 - idx))
    chunk_decay = jnp.exp(log_gamma * BLOCK)
    qc = q.astype(f32).reshape(b, h, nc, BLOCK, dh)
    kc = k.astype(f32).reshape(b, h, nc, BLOCK, dh) * (dh ** -0.5)
    vc = v.astype(f32).reshape(b, h, nc, BLOCK, dh)
    scores = jnp.einsum('bhntd,bhnsd->bhnts', qc, kc) * intra_decay[None, :, None]
    intra = jnp.einsum('bhnts,bhnse->bhnte', scores, vc)
    kv = jnp.einsum('bhnsd,bhnse->nbhde', kc * k_decay[None, :, None, :, None], vc)

    def step(state, kv_n):
        return state * chunk_decay[None, :, None, None] + kv_n, state

    _, prev = lax.scan(step, jnp.zeros((b, h, dh, dh), f32), kv)
    cross = jnp.einsum('bhntd,nbhde->bhnte', qc * q_decay[None, :, None, :, None], prev)
    out = (intra + cross).reshape(b, h, s, dh)
    out = out * lax.rsqrt(jnp.mean(out * out, axis=-1, keepdims=True) + EPS)
    return out.astype(q.dtype)


def even_layer(x, c, norm_g, w_mod, b_mod, w_in, a_vnorm_g, a_ws, a_bs, b_qnorm_g, b_knorm_g, w_out):
    shift, scale, gate = ada_modulation(c, w_mod, b_mod)
    hdn = rms_norm(x, norm_g) * (1.0 + scale) + shift
    p = hdn @ w_in
    u, v, q, k, val, z = jnp.split(p, list(EVEN_SPLITS), axis=-1)
    a_out = chunked_spatial_gating(u, v, a_vnorm_g, a_ws, a_bs)
    qh = rms_norm(to_heads(q, B_HEADS, B_HEAD_DIM), b_qnorm_g)
    kh = rms_norm(to_heads(k, B_HEADS, B_HEAD_DIM), b_knorm_g)
    b_out = from_heads(stick_breaking_attention(qh, kh, to_heads(val, B_HEADS, B_HEAD_DIM)))
    y = jnp.concatenate([a_out, b_out], axis=-1) * jax.nn.silu(z)
    return x + gate * (y @ w_out)


def odd_layer(x, c, positions, norm_g, w_mod, b_mod, w_in, c_w, c_scale, d_qnorm_g, d_knorm_g, w_out):
    shift, scale, gate = ada_modulation(c, w_mod, b_mod)
    hdn = rms_norm(x, norm_g) * (1.0 + scale) + shift
    p = hdn @ w_in
    pc, q, k, val, z = jnp.split(p, list(ODD_SPLITS), axis=-1)
    c_out = multiscale_pool(pc, c_w, c_scale)
    qh = rotary(rms_norm(to_heads(q, D_HEADS, D_HEAD_DIM), d_qnorm_g), positions)
    kh = rotary(rms_norm(to_heads(k, D_HEADS, D_HEAD_DIM), d_knorm_g), positions)
    d_out = from_heads(retention_chunkwise(qh, kh, to_heads(val, D_HEADS, D_HEAD_DIM)))
    y = jnp.concatenate([c_out, d_out], axis=-1) * jax.nn.silu(z)
    return x + gate * (y @ w_out)


def setup_inputs(seed: int = 0) -> dict:
    key = jax.random.key(seed)
    ks = iter(jax.random.split(key, 32))
    f32 = jnp.float32
    ne = (DEPTH + 1) // 2
    no = DEPTH // 2

    def nrm(shape, s):
        return jax.random.normal(next(ks), shape, f32) * s

    x = nrm((BATCH, SEQ, D_MODEL), 1.0)
    c = nrm((BATCH, D_MODEL), 1.0)
    offsets = jax.random.randint(next(ks), (BATCH, 1), 0, 1024, dtype=jnp.int32)
    positions = jnp.arange(SEQ, dtype=jnp.int32)[None, :] + offsets
    return {
        "x": x, "c": c, "positions": positions,
        "even_norm_g": 1.0 + nrm((ne, D_MODEL), 0.02),
        "even_w_mod": nrm((ne, D_MODEL, 3 * D_MODEL), 0.5 * D_MODEL ** -0.5),
        "even_b_mod": nrm((ne, 3 * D_MODEL), 0.02),
        "even_w_in": nrm((ne, D_MODEL, EVEN_IN), D_MODEL ** -0.5),
        "even_a_vnorm_g": 1.0 + nrm((ne, A_GROUPS, A_GROUP_DIM), 0.02),
        "even_a_ws": nrm((ne, A_GROUPS, BLOCK, BLOCK), BLOCK ** -0.5),
        "even_a_bs": 1.0 + nrm((ne, A_GROUPS, BLOCK), 0.1),
        "even_b_qnorm_g": 1.0 + nrm((ne, B_HEAD_DIM), 0.02),
        "even_b_knorm_g": 1.0 + nrm((ne, B_HEAD_DIM), 0.02),
        "even_w_out": nrm((ne, D_INNER, D_MODEL), D_INNER ** -0.5),
        "odd_norm_g": 1.0 + nrm((no, D_MODEL), 0.02),
        "odd_w_mod": nrm((no, D_MODEL, 3 * D_MODEL), 0.5 * D_MODEL ** -0.5),
        "odd_b_mod": nrm((no, 3 * D_MODEL), 0.02),
        "odd_w_in": nrm((no, D_MODEL, ODD_IN), D_MODEL ** -0.5),
        "odd_c_w": nrm((no, C_GROUPS, C_GROUP_DIM, C_GROUP_DIM), C_GROUP_DIM ** -0.5),
        "odd_c_scale": 1.0 + nrm((no, C_WIDTH), 0.1),
        "odd_d_qnorm_g": 1.0 + nrm((no, D_HEAD_DIM), 0.02),
        "odd_d_knorm_g": 1.0 + nrm((no, D_HEAD_DIM), 0.02),
        "odd_w_out": nrm((no, D_INNER, D_MODEL), D_INNER ** -0.5),
    }


def reference(x, c, positions,
              even_norm_g, even_w_mod, even_b_mod, even_w_in, even_a_vnorm_g, even_a_ws, even_a_bs,
              even_b_qnorm_g, even_b_knorm_g, even_w_out,
              odd_norm_g, odd_w_mod, odd_b_mod, odd_w_in, odd_c_w, odd_c_scale,
              odd_d_qnorm_g, odd_d_knorm_g, odd_w_out):
    for layer in range(DEPTH):
        i = layer // 2
        if layer % 2 == 0:
            x = even_layer(x, c, even_norm_g[i], even_w_mod[i], even_b_mod[i], even_w_in[i],
                           even_a_vnorm_g[i], even_a_ws[i], even_a_bs[i],
                           even_b_qnorm_g[i], even_b_knorm_g[i], even_w_out[i])
        else:
            x = odd_layer(x, c, positions, odd_norm_g[i], odd_w_mod[i], odd_b_mod[i], odd_w_in[i],
                          odd_c_w[i], odd_c_scale[i], odd_d_qnorm_g[i], odd_d_knorm_g[i], odd_w_out[i])
    return x
```

```cpp
#include <hip/hip_runtime.h>
#include <hip/hip_cooperative_groups.h>
#include <cstdio>
namespace cg = cooperative_groups;

typedef unsigned short u16;
using bf16x8 = __attribute__((ext_vector_type(8))) short;
using bf16x4 = __attribute__((ext_vector_type(4))) short;
using f32x4  = __attribute__((ext_vector_type(4))) float;

#define NTHREADS 256
constexpr int TOK = 16384, DM = 1024, SEQ = 4096;
constexpr int EVEN_IN = 7168, ODD_IN = 6144;
constexpr size_t MiB = 1u << 20;
constexpr size_t OFF_WIN1T  = 0;
constexpr size_t OFF_WOUT1T = 12 * MiB;
constexpr size_t OFF_CWT    = 16 * MiB;
constexpr size_t OFF_WS     = 16 * MiB + 512 * 1024;
constexpr size_t OFF_MODP   = 16 * MiB + 768 * 1024;
constexpr size_t OFF_BAR    = 17 * MiB + 512 * 1024;
constexpr size_t OFF_ROPEC  = 18 * MiB;
constexpr size_t OFF_ROPES  = 22 * MiB;
constexpr size_t OFF_WIN0T  = 26 * MiB;
constexpr size_t OFF_WOUT0T = 40 * MiB;
constexpr size_t OFF_PC     = 26 * MiB;
constexpr size_t OFF_HDN    = 58 * MiB;
constexpr size_t OFF_STATE  = 58 * MiB;
constexpr size_t OFF_Y      = 90 * MiB;
constexpr size_t OFF_Q      = 154 * MiB;
constexpr size_t OFF_K      = 186 * MiB;
constexpr size_t OFF_VT     = 218 * MiB;
constexpr size_t WS_NEED    = 250 * MiB;
constexpr size_t OFF_U      = 0;
constexpr size_t OFF_VNT    = 32 * MiB;

struct Params {
  const float* x; const float* c; const int* pos;
  const float* e_norm_g; const float* e_w_mod; const float* e_b_mod; const float* e_w_in;
  const float* e_vg; const float* e_ws; const float* e_bs; const float* e_qg; const float* e_kg; const float* e_w_out;
  const float* o_norm_g; const float* o_w_mod; const float* o_b_mod; const float* o_w_in;
  const float* o_cw; const float* o_cscale; const float* o_qg; const float* o_kg; const float* o_w_out;
  float* out; char* ws;
};

__device__ __forceinline__ u16 f2bf(float f) {
  unsigned u = __float_as_uint(f);
  u += 0x7fffu + ((u >> 16) & 1u);
  return (u16)(u >> 16);
}
__device__ __forceinline__ float bf2f(u16 h) { return __uint_as_float(((unsigned)h) << 16); }
__device__ __forceinline__ float silu_f(float v) { return v / (1.f + __expf(-v)); }

#define WAITV(n) asm volatile("s_waitcnt vmcnt(" #n ")" ::: "memory")
#define BAR() __builtin_amdgcn_s_barrier()

__device__ __forceinline__ void glds16(const void* g, void* l) {
  __builtin_amdgcn_global_load_lds((const unsigned*)g, (__attribute__((address_space(3))) unsigned*)l, 16, 0, 0);
}

__device__ __forceinline__ void stage128x64(const u16* g, size_t ld, char* lds) {
  const int tid = threadIdx.x;
  const int c = (tid & 7) ^ ((tid >> 4) & 7);
  const u16* src = g + (size_t)(tid >> 3) * ld + c * 8;
  char* dst = lds + tid * 16;
#pragma unroll
  for (int i = 0; i < 4; ++i) glds16(src + (size_t)(i * 32) * ld, dst + i * 4096);
}

__device__ __forceinline__ void mma_ktile(const char* sA, const char* sB, f32x4 (&acc)[2][8]) {
  const int lane = threadIdx.x & 63, w = threadIdx.x >> 6, fr = lane & 15, fq = lane >> 4;
  const int sw = (fr >> 1) & 7;
#pragma unroll
  for (int ks = 0; ks < 2; ++ks) {
    const int cp = ((ks * 4 + fq) ^ sw) * 16;
    bf16x8 a[2], b[8];
#pragma unroll
    for (int m = 0; m < 2; ++m) a[m] = *(const bf16x8*)(sA + (w * 32 + m * 16 + fr) * 128 + cp);
#pragma unroll
    for (int n = 0; n < 8; ++n) b[n] = *(const bf16x8*)(sB + (n * 16 + fr) * 128 + cp);
#pragma unroll
    for (int m = 0; m < 2; ++m)
#pragma unroll
      for (int n = 0; n < 8; ++n)
        acc[m][n] = __builtin_amdgcn_mfma_f32_16x16x32_bf16(a[m], b[n], acc[m][n], 0, 0, 0);
  }
  __builtin_amdgcn_iglp_opt(1);
}

__device__ __forceinline__ void gemm_main(const u16* A, size_t lda, const u16* B, size_t ldb, int K, f32x4 (&acc)[2][8], char* smem) {
  const int nk = K >> 6;
  BAR();
  stage128x64(A, lda, smem);
  stage128x64(B, ldb, smem + 16384);
  for (int kt = 0; kt < nk; ++kt) {
    char* cur = smem + (kt & 1) * 32768;
    WAITV(0);
    BAR();
    if (kt + 1 < nk) {
      char* nxt = smem + ((kt + 1) & 1) * 32768;
      stage128x64(A + (kt + 1) * 64, lda, nxt);
      stage128x64(B + (kt + 1) * 64, ldb, nxt + 16384);
    }
    mma_ktile(cur, cur + 16384, acc);
  }
  BAR();
}

__device__ __forceinline__ void zero_acc(f32x4 (&acc)[2][8]) {
#pragma unroll
  for (int m = 0; m < 2; ++m)
#pragma unroll
    for (int n = 0; n < 8; ++n) acc[m][n] = f32x4{0.f, 0.f, 0.f, 0.f};
}

__device__ __forceinline__ void row_sumsq(const f32x4 (&acc)[2][8], float (&ss)[2][4]) {
#pragma unroll
  for (int m = 0; m < 2; ++m)
#pragma unroll
    for (int j = 0; j < 4; ++j) {
      float s = 0.f;
#pragma unroll
      for (int n = 0; n < 8; ++n) s += acc[m][n][j] * acc[m][n][j];
      s += __shfl_xor(s, 1); s += __shfl_xor(s, 2); s += __shfl_xor(s, 4); s += __shfl_xor(s, 8);
      ss[m][j] = s;
    }
}

template <class F>
__device__ __forceinline__ void epi_rows(const f32x4 (&acc)[2][8], char* slab, F f) {
  const int lane = threadIdx.x & 63, w = threadIdx.x >> 6, fr = lane & 15, fq = lane >> 4;
  float* st = (float*)slab + w * (16 * 128);
#pragma unroll
  for (int m = 0; m < 2; ++m) {
#pragma unroll
    for (int n = 0; n < 8; ++n)
#pragma unroll
      for (int j = 0; j < 4; ++j) st[(fq * 4 + j) * 128 + ((n * 16 + fr + 8 * fq) & 127)] = acc[m][n][j];
    asm volatile("" ::: "memory");
#pragma unroll
    for (int it = 0; it < 4; ++it) {
      const int r = it * 4 + fq;
      const float* rp = st + r * 128 + ((fr * 8 + 8 * it) & 127);
      const f32x4 lo = *(const f32x4*)rp, hi = *(const f32x4*)(rp + 4);
      float v[8] = {lo[0], lo[1], lo[2], lo[3], hi[0], hi[1], hi[2], hi[3]};
      f(w * 32 + m * 16 + r, fr * 8, v);
    }
    asm volatile("" ::: "memory");
  }
}
__device__ __forceinline__ bf16x8 pack8(const float (&v)[8]) {
  bf16x8 o;
#pragma unroll
  for (int e = 0; e < 8; ++e) o[e] = (short)f2bf(v[e]);
  return o;
}
__device__ __forceinline__ void store_nat(const f32x4 (&v)[2][8], u16* dst, size_t ld, char* smem) {
  epi_rows(v, smem, [&](int row, int col, const float (&x)[8]) { *(bf16x8*)(dst + (size_t)row * ld + col) = pack8(x); });
}
__device__ __forceinline__ void store_tr(const f32x4 (&v)[2][8], u16* dst, size_t ld, char* smem) {
  const int tid = threadIdx.x, lane = tid & 63, w = tid >> 6, fr = lane & 15, fq = lane >> 4;
#pragma unroll
  for (int m = 0; m < 2; ++m)
#pragma unroll
    for (int n = 0; n < 8; ++n) {
      bf16x4 pk;
#pragma unroll
      for (int j = 0; j < 4; ++j) pk[j] = (short)f2bf(v[m][n][j]);
      *(bf16x4*)(smem + (n * 16 + fr) * 272 + (w * 32 + m * 16 + fq * 4) * 2) = pk;
    }
  __syncthreads();
#pragma unroll
  for (int it = 0; it < 8; ++it) {
    const int idx = it * 256 + tid, col = idx >> 4, seg = idx & 15;
    *(bf16x8*)(dst + (size_t)col * ld + seg * 8) = *(const bf16x8*)(smem + col * 272 + seg * 16);
  }
}

__device__ __forceinline__ void transpose_job(const float* src, int R, int C, u16* dst, int tile, float* lds) {
  const int tc = C >> 6;
  const int r0 = (tile / tc) * 64, c0 = (tile % tc) * 64;
  const int tid = threadIdx.x;
#pragma unroll
  for (int i = 0; i < 4; ++i) {
    int r = (tid >> 4) + 16 * i, c4 = (tid & 15) * 4;
    float4 v = *(const float4*)(src + (size_t)(r0 + r) * C + c0 + c4);
    float* d = lds + r * 65 + c4;
    d[0] = v.x; d[1] = v.y; d[2] = v.z; d[3] = v.w;
  }
  __syncthreads();
  {
    int c = tid >> 2, rb = (tid & 3) * 16;
    bf16x8 o0, o1;
#pragma unroll
    for (int i = 0; i < 8; ++i) { o0[i] = (short)f2bf(lds[(rb + i) * 65 + c]); o1[i] = (short)f2bf(lds[(rb + 8 + i) * 65 + c]); }
    u16* d = dst + (size_t)(c0 + c) * R + r0 + rb;
    *(bf16x8*)d = o0; *(bf16x8*)(d + 8) = o1;
  }
  __syncthreads();
}

__device__ __forceinline__ void phase0(const Params& p, char* smem) {
  float* lds = (float*)smem;
  char* ws = p.ws;
  const int tid = threadIdx.x;
  constexpr int J_T0 = 1792, J_T1 = J_T0 + 512, J_T2 = J_T1 + 1536, J_T3 = J_T2 + 512, J_T4 = J_T3 + 64;
  constexpr int J_MOD = J_T4 + 768, J_ROPE = J_MOD + 1024, J_WS = J_ROPE + 128;
  for (int job0 = blockIdx.x; job0 < J_WS; job0 += gridDim.x) {
    const int job = (job0 < 768) ? (J_T4 + job0) : ((job0 - 768 < J_T4) ? (job0 - 768) : job0);
    if (job < J_T0)      transpose_job(p.e_w_in, 1024, EVEN_IN, (u16*)(ws + OFF_WIN0T), job, lds);
    else if (job < J_T1) transpose_job(p.e_w_out, 2048, 1024, (u16*)(ws + OFF_WOUT0T), job - J_T0, lds);
    else if (job < J_T2) transpose_job(p.o_w_in, 1024, ODD_IN, (u16*)(ws + OFF_WIN1T), job - J_T1, lds);
    else if (job < J_T3) transpose_job(p.o_w_out, 2048, 1024, (u16*)(ws + OFF_WOUT1T), job - J_T2, lds);
    else if (job < J_T4) { int q = job - J_T3, g = q >> 4; transpose_job(p.o_cw + (size_t)g * 65536, 256, 256, (u16*)(ws + OFF_CWT) + (size_t)g * 65536, q & 15, lds); }
    else if (job < J_MOD) {
      int q = job - J_T4; int layer = q / 384; q %= 384; int ks = q / 48, jb = q % 48;
      const float* wm = layer ? p.o_w_mod : p.e_w_mod; const float* bm = layer ? p.o_b_mod : p.e_b_mod;
      const int wv_ = tid >> 6, jl = tid & 63, j = jb * 64 + jl;
      __syncthreads();
      for (int i = tid; i < 512; i += NTHREADS) { int bb = i >> 7, kk = i & 127; lds[i] = silu_f(p.c[bb * 1024 + ks * 128 + kk]); }
      __syncthreads();
      float a0 = 0.f, a1 = 0.f, a2 = 0.f, a3 = 0.f;
      const float* wp = wm + (size_t)(ks * 128 + wv_ * 32) * 3072 + j;
      float wl[32];
#pragma unroll
      for (int k = 0; k < 32; ++k) wl[k] = wp[(size_t)k * 3072];
#pragma unroll
      for (int k = 0; k < 32; ++k) {
        const int kk = wv_ * 32 + k;
        a0 += lds[kk] * wl[k]; a1 += lds[128 + kk] * wl[k]; a2 += lds[256 + kk] * wl[k]; a3 += lds[384 + kk] * wl[k];
      }
      float* red = lds + 512;
      red[(wv_ * 4 + 0) * 64 + jl] = a0; red[(wv_ * 4 + 1) * 64 + jl] = a1; red[(wv_ * 4 + 2) * 64 + jl] = a2; red[(wv_ * 4 + 3) * 64 + jl] = a3;
      __syncthreads();
      {
        const int bb = tid >> 6;
        float r = red[(0 * 4 + bb) * 64 + jl] + red[(1 * 4 + bb) * 64 + jl] + red[(2 * 4 + bb) * 64 + jl] + red[(3 * 4 + bb) * 64 + jl];
        if (ks == 0) r += bm[j];
        ((float*)(ws + OFF_MODP))[(size_t)((layer * 8 + ks) * 4 + bb) * 3072 + j] = r;
      }
      __syncthreads();
    } else if (job < J_ROPE) {
      int q = job - J_MOD;
      float* rc = (float*)(ws + OFF_ROPEC); float* rs = (float*)(ws + OFF_ROPES);
#pragma unroll
      for (int i = 0; i < 4; ++i) {
        int e = q * 1024 + i * 256 + tid; int t = e >> 6, j = e & 63;
        float invf = (float)exp2(-(double)j * (13.287712379549449 / 64.0));
        float ang = (float)p.pos[t] * invf;
        double rev = (double)ang * 0.15915494309189535;
        float fr = (float)(rev - rint(rev));
        rc[e] = __builtin_amdgcn_cosf(fr); rs[e] = __builtin_amdgcn_sinf(fr);
      }
    } else {
      int q = job - J_ROPE;
      u16* wsb = (u16*)(ws + OFF_WS);
#pragma unroll
      for (int i = 0; i < 4; ++i) {
        int e = q * 1024 + i * 256 + tid; int t = (e >> 7) & 127, s = e & 127;
        wsb[e] = (s <= t) ? f2bf(p.e_ws[e]) : (u16)0;
      }
    }
  }
}

__device__ __forceinline__ void phase_hdn(const Params& p, int layer, char* smem) {
  const float* xin = layer ? p.out : p.x;
  const float* ng = layer ? p.o_norm_g : p.e_norm_g;
  const float* modp = (const float*)(p.ws + OFF_MODP) + (size_t)layer * 8 * 4 * 3072;
  u16* hdn = (u16*)(p.ws + OFF_HDN);
  float* mul = (float*)smem; float* add = mul + 1024;
  const int tid = threadIdx.x, lane = tid & 63, w = tid >> 6;
  for (int chunk = blockIdx.x; chunk < 512; chunk += gridDim.x) {
    const int b = chunk >> 7;
    __syncthreads();
    for (int k = tid; k < 1024; k += NTHREADS) {
      float sh = 0.f, sc = 0.f;
#pragma unroll
      for (int ks = 0; ks < 8; ++ks) { const float* mp = modp + (size_t)(ks * 4 + b) * 3072; sh += mp[k]; sc += mp[1024 + k]; }
      mul[k] = ng[k] * (1.f + sc); add[k] = sh;
    }
    __syncthreads();
    for (int r = 0; r < 8; r += 4) {
      const int t = chunk * 32 + w * 8 + r;
      float4 v[4][4]; float ss[4];
#pragma unroll
      for (int u = 0; u < 4; ++u) {
        const float* xr = xin + (size_t)(t + u) * 1024;
#pragma unroll
        for (int i = 0; i < 4; ++i) v[u][i] = *(const float4*)(xr + i * 256 + lane * 4);
      }
#pragma unroll
      for (int u = 0; u < 4; ++u) {
        float a = 0.f;
#pragma unroll
        for (int i = 0; i < 4; ++i) a += v[u][i].x * v[u][i].x + v[u][i].y * v[u][i].y + v[u][i].z * v[u][i].z + v[u][i].w * v[u][i].w;
#pragma unroll
        for (int o = 1; o < 64; o <<= 1) a += __shfl_xor(a, o);
        ss[u] = rsqrtf(a * (1.f / 1024.f) + 1e-6f);
      }
#pragma unroll
      for (int i = 0; i < 4; ++i) {
        const int k = i * 256 + lane * 4;
        const float4 mu = *(const float4*)(mul + k), ad = *(const float4*)(add + k);
#pragma unroll
        for (int u = 0; u < 4; ++u) {
          bf16x4 o;
          o[0] = (short)f2bf(v[u][i].x * ss[u] * mu.x + ad.x);
          o[1] = (short)f2bf(v[u][i].y * ss[u] * mu.y + ad.y);
          o[2] = (short)f2bf(v[u][i].z * ss[u] * mu.z + ad.z);
          o[3] = (short)f2bf(v[u][i].w * ss[u] * mu.w + ad.w);
          *(bf16x4*)(hdn + (size_t)(t + u) * 1024 + k) = o;
        }
      }
    }
  }
}

__device__ __forceinline__ void phase_inproj(const Params& p, int layer, char* smem) {
  const int NT = layer ? 48 : 56;
  const u16* hdn = (const u16*)(p.ws + OFF_HDN);
  const u16* wt = (const u16*)(p.ws + (layer ? OFF_WIN1T : OFF_WIN0T));
  u16* Yb = (u16*)(p.ws + OFF_Y); u16* Qb = (u16*)(p.ws + OFF_Q); u16* Kb = (u16*)(p.ws + OFF_K); u16* VTb = (u16*)(p.ws + OFF_VT);
  const int lane = threadIdx.x & 63, w = threadIdx.x >> 6, fr = lane & 15, fq = lane >> 4;
  const int ntiles = 128 * NT;
  for (int tile = blockIdx.x; tile < ntiles; tile += gridDim.x) {
    const int sup = (tile & 7) + 8 * (tile / 512), within = (tile >> 3) & 63;
    const int nsn = NT / 8;
    const int mt = (sup / nsn) * 8 + (within & 7), nt = (sup % nsn) * 8 + (within >> 3);
    f32x4 acc[2][8]; zero_acc(acc);
    gemm_main(hdn + (size_t)mt * 128 * 1024, 1024, wt + (size_t)nt * 128 * 1024, 1024, 1024, acc, smem);
    const int kind = nt >> 3, sub = nt & 7;
    const size_t t0 = (size_t)mt * 128;
    const int zk = layer ? 4 : 5;
    u16* dst; size_t ld; bool tr = false;
    if (kind >= zk) {
#pragma unroll
      for (int m = 0; m < 2; ++m)
#pragma unroll
        for (int n = 0; n < 8; ++n)
#pragma unroll
          for (int j = 0; j < 4; ++j) acc[m][n][j] = silu_f(acc[m][n][j]);
      dst = Yb + t0 * 2048 + (nt - zk * 8) * 128; ld = 2048;
    } else if (kind == zk - 1) {
      const int b = mt >> 5, s0 = (mt & 31) * 128;
      dst = VTb + ((size_t)(b * 8 + sub) * 128) * 4096 + s0; ld = 4096; tr = true;
    } else if (kind == 0) {
      dst = (layer == 0 ? (u16*)((char*)p.out + OFF_U) : (u16*)(p.ws + OFF_PC)) + t0 * 1024 + sub * 128; ld = 1024;
    } else {
      const bool isv = (layer == 0 && kind == 1);
      const bool isq = (layer == 0) ? (kind == 2) : (kind == 1);
      const float* gn = isv ? (p.e_vg + sub * 128) : ((layer == 0) ? (isq ? p.e_qg : p.e_kg) : (isq ? p.o_qg : p.o_kg));
      const float fold = isv ? 1.f : (((layer == 0) == isq) ? (layer == 0 ? 0.08838834764831845f * 1.4426950408889634f : 0.08838834764831845f) : 1.f);
      float ss[2][4]; row_sumsq(acc, ss);
      float gv[8];
#pragma unroll
      for (int n = 0; n < 8; ++n) gv[n] = gn[n * 16 + fr];
#pragma unroll
      for (int m = 0; m < 2; ++m)
#pragma unroll
        for (int j = 0; j < 4; ++j) {
          const float rstd = rsqrtf(ss[m][j] * (1.f / 128.f) + 1e-6f);
#pragma unroll
          for (int n = 0; n < 8; ++n) acc[m][n][j] *= rstd * gv[n];
        }
      if (layer == 1) {
        const float* rc = (const float*)(p.ws + OFF_ROPEC); const float* rs = (const float*)(p.ws + OFF_ROPES);
#pragma unroll
        for (int m = 0; m < 2; ++m)
#pragma unroll
          for (int j = 0; j < 4; ++j) {
            const size_t t = t0 + w * 32 + m * 16 + fq * 4 + j;
#pragma unroll
            for (int n = 0; n < 4; ++n) {
              const float cs = rc[t * 64 + n * 16 + fr], sn = rs[t * 64 + n * 16 + fr];
              const float x1 = acc[m][n][j], x2 = acc[m][n + 4][j];
              acc[m][n][j] = (x1 * cs - x2 * sn) * fold; acc[m][n + 4][j] = (x1 * sn + x2 * cs) * fold;
            }
            __builtin_amdgcn_sched_barrier(0);
          }
      } else if (fold != 1.f) {
#pragma unroll
        for (int m = 0; m < 2; ++m)
#pragma unroll
          for (int n = 0; n < 8; ++n) acc[m][n] *= fold;
      }
      if (isv) { dst = (u16*)((char*)p.out + OFF_VNT) + (size_t)(mt * 8 + sub) * 16384; ld = 128; tr = true; }
      else { dst = (isq ? Qb : Kb) + t0 * 1024 + sub * 128; ld = 1024; }
    }
    __builtin_amdgcn_sched_barrier(0);
    if (tr) store_tr(acc, dst, ld, smem); else store_nat(acc, dst, ld, smem);
  }
}

__device__ __forceinline__ void phase_outproj(const Params& p, int layer, char* smem) {
  const u16* Yb = (const u16*)(p.ws + OFF_Y);
  const u16* wt = (const u16*)(p.ws + (layer ? OFF_WOUT1T : OFF_WOUT0T));
  const float* xin = layer ? p.out : p.x;
  const float* modp = (const float*)(p.ws + OFF_MODP) + (size_t)layer * 8 * 4 * 3072;
  const int lane = threadIdx.x & 63, w = threadIdx.x >> 6, fr = lane & 15, fq = lane >> 4;
  for (int tile = blockIdx.x; tile < 1024; tile += gridDim.x) {
    const int sup = (tile & 7) + 8 * (tile / 512), within = (tile >> 3) & 63;
    const int mt = sup * 8 + (within & 7), nt = within >> 3;
    f32x4 acc[2][8]; zero_acc(acc);
    gemm_main(Yb + (size_t)mt * 128 * 2048, 2048, wt + (size_t)nt * 128 * 2048, 2048, 2048, acc, smem);
    const int b = mt >> 5;
    float gate[8];
    {
      f32x4 g0 = {0.f, 0.f, 0.f, 0.f}, g1 = {0.f, 0.f, 0.f, 0.f};
#pragma unroll
      for (int ks = 0; ks < 8; ++ks) {
        const float* gp = modp + (size_t)(ks * 4 + b) * 3072 + 2048 + nt * 128 + fr * 8;
        g0 += *(const f32x4*)gp; g1 += *(const f32x4*)(gp + 4);
      }
#pragma unroll
      for (int e = 0; e < 4; ++e) { gate[e] = g0[e]; gate[4 + e] = g1[e]; }
    }
    epi_rows(acc, smem, [&](int row, int col, const float (&v)[8]) {
      const size_t o = ((size_t)mt * 128 + row) * 1024 + nt * 128 + col;
      const f32x4 x0 = *(const f32x4*)(xin + o), x1 = *(const f32x4*)(xin + o + 4);
      f32x4 r0, r1;
#pragma unroll
      for (int e = 0; e < 4; ++e) { r0[e] = x0[e] + gate[e] * v[e]; r1[e] = x1[e] + gate[4 + e] * v[4 + e]; }
      *(f32x4*)(p.out + o) = r0; *(f32x4*)(p.out + o + 4) = r1;
    });
  }
}

__device__ __forceinline__ void gmlp_tile(const Params& p, int tile, char* smem) {
  const int chunk = tile >> 3, g = tile & 7;
  const int lane = threadIdx.x & 63, w = threadIdx.x >> 6, fr = lane & 15, fq = lane >> 4;
  f32x4 acc[2][8]; zero_acc(acc);
  gemm_main((const u16*)(p.ws + OFF_WS) + (size_t)g * 16384, 128, (const u16*)((char*)p.out + OFF_VNT) + (size_t)tile * 16384, 128, 128, acc, smem);
  const u16* U = (const u16*)((char*)p.out + OFF_U);
  u16* Yb = (u16*)(p.ws + OFF_Y);
  epi_rows(acc, smem, [&](int row, int col, const float (&v)[8]) {
    const float bs = p.e_bs[g * 128 + row];
    const size_t t = (size_t)chunk * 128 + row;
    const bf16x8 uu = *(const bf16x8*)(U + t * 1024 + g * 128 + col);
    u16* yp = Yb + t * 2048 + g * 128 + col;
    const bf16x8 yy = *(const bf16x8*)yp;
    bf16x8 o;
#pragma unroll
    for (int e = 0; e < 8; ++e) o[e] = (short)f2bf((v[e] + bs) * bf2f((u16)uu[e]) * bf2f((u16)yy[e]));
    *(bf16x8*)yp = o;
  });
}

__device__ __forceinline__ void attn_tile(const Params& p, int tile, char* smem) {
  const int qb = 63 - (tile & 63), h = (tile >> 6) & 7, b = tile >> 9;
  const int tid = threadIdx.x, lane = tid & 63, w = tid >> 6, fr = lane & 15, fq = lane >> 4;
  const u16* Qb = (const u16*)(p.ws + OFF_Q); const u16* Kb = (const u16*)(p.ws + OFF_K); const u16* VTb = (const u16*)(p.ws + OFF_VT);
  u16* Yb = (u16*)(p.ws + OFF_Y);
  const int q0 = qb * 64;
  const size_t tb = (size_t)b * SEQ;
  float* red = (float*)(smem + 65536);
  const int t = q0 + w * 16 + fr;
  bf16x8 qf[4];
#pragma unroll
  for (int ks = 0; ks < 4; ++ks) qf[ks] = *(const bf16x8*)(Qb + (tb + t) * 1024 + h * 128 + ks * 32 + fq * 8);
  f32x4 O[8];
#pragma unroll
  for (int md = 0; md < 8; ++md) O[md] = f32x4{0.f, 0.f, 0.f, 0.f};
  float carry = 0.f;
  auto stage_kv = [&](int kt_, char* buf) {
    const int key0_ = kt_ * 64;
    const int c = (tid & 15) ^ ((tid >> 4) & 15);
    const u16* src = Kb + (tb + key0_ + (tid >> 4)) * 1024 + h * 128 + c * 8;
#pragma unroll
    for (int i = 0; i < 4; ++i) glds16(src + (size_t)(i * 16) * 1024, buf + i * 4096 + tid * 16);
    stage128x64(VTb + ((size_t)(b * 8 + h) * 128) * 4096 + key0_, 4096, buf + 16384);
  };
  __syncthreads();
  stage_kv(qb, smem);
  WAITV(0);
  __syncthreads();
  for (int kt = qb; kt >= 0; --kt) {
    const int key0 = kt * 64;
    char* sK = smem + ((qb - kt) & 1) * 32768; char* sV = sK + 16384;
    if (kt > 0) stage_kv(kt - 1, smem + ((qb - kt + 1) & 1) * 32768);
    {
      f32x4 S[4];
#pragma unroll
      for (int m = 0; m < 4; ++m) S[m] = f32x4{0.f, 0.f, 0.f, 0.f};
#pragma unroll
      for (int ks = 0; ks < 4; ++ks)
#pragma unroll
        for (int m = 0; m < 4; ++m) {
          const bf16x8 kf = *(const bf16x8*)(sK + (m * 16 + fr) * 256 + (((ks * 4 + fq) ^ fr) * 16));
          S[m] = __builtin_amdgcn_mfma_f32_16x16x32_bf16(kf, qf[ks], S[m], 0, 0, 0);
        }
      float run = carry;
      float wv[4][4];
#pragma unroll
      for (int m = 3; m >= 0; --m) {
        float a[4];
        float gs = 0.f;
#pragma unroll
        for (int j = 0; j < 4; ++j) {
          const int s = key0 + m * 16 + fq * 4 + j;
          const float z = S[m][j];
          const float sp = fmaxf(z, 0.f) + __builtin_amdgcn_logf(1.f + __builtin_amdgcn_exp2f(-fabsf(z)));
          a[j] = (s < t) ? -sp : 0.f;
          gs += a[j];
        }
        const float v1 = __shfl_xor(gs, 16), v2 = __shfl_xor(gs, 32), v3 = __shfl_xor(v1, 32);
        const float tot = gs + v1 + v2 + v3;
        const float above = (((fq ^ 1) > fq) ? v1 : 0.f) + (((fq ^ 2) > fq) ? v2 : 0.f) + (((fq ^ 3) > fq) ? v3 : 0.f);
        const float base = run + above;
        float suf = 0.f;
#pragma unroll
        for (int j = 3; j >= 0; --j) {
          const bool valid = (key0 + m * 16 + fq * 4 + j) < t;
          wv[m][j] = valid ? __builtin_amdgcn_exp2f(S[m][j] + a[j] + base + suf) : 0.f;
          suf += a[j];
        }
        run += tot;
      }
      carry = run;
      bf16x8 pf[2];
#pragma unroll
      for (int c = 0; c < 2; ++c)
#pragma unroll
        for (int j = 0; j < 4; ++j) { pf[c][j] = (short)f2bf(wv[2 * c][j]); pf[c][4 + j] = (short)f2bf(wv[2 * c + 1][j]); }
#pragma unroll
      for (int c = 0; c < 2; ++c)
#pragma unroll
        for (int md = 0; md < 8; ++md) {
          const char* rowp = sV + (md * 16 + fr) * 128;
          const int sw = (fr >> 1) & 7;
          const int qa = 8 * c + fq, qb2 = qa + 4;
          const bf16x4 lo = *(const bf16x4*)(rowp + (((qa >> 1) ^ sw) * 16) + (qa & 1) * 8);
          const bf16x4 hi = *(const bf16x4*)(rowp + (((qb2 >> 1) ^ sw) * 16) + (qb2 & 1) * 8);
          bf16x8 vf;
          vf[0] = lo[0]; vf[1] = lo[1]; vf[2] = lo[2]; vf[3] = lo[3]; vf[4] = hi[0]; vf[5] = hi[1]; vf[6] = hi[2]; vf[7] = hi[3];
          O[md] = __builtin_amdgcn_mfma_f32_16x16x32_bf16(vf, pf[c], O[md], 0, 0, 0);
        }
    }
    float cm = carry;
#pragma unroll
    for (int o = 1; o < 16; o <<= 1) cm = fmaxf(cm, __shfl_xor(cm, o));
    if (lane == 0) red[w] = cm;
    WAITV(0);
    __syncthreads();
    const float allmax = fmaxf(fmaxf(red[0], red[1]), fmaxf(red[2], red[3]));
    if (allmax < -160.f) break;
  }
  {
    float* st = (float*)smem + w * (16 * 132);
#pragma unroll
    for (int md = 0; md < 8; ++md) *(f32x4*)(st + fr * 132 + md * 16 + fq * 4) = O[md];
#pragma unroll
    for (int it = 0; it < 4; ++it) {
      const int r = it * 4 + fq;
      const float* rp = st + r * 132 + fr * 8;
      const f32x4 lo = *(const f32x4*)rp, hi = *(const f32x4*)(rp + 4);
      u16* yp = Yb + (tb + q0 + w * 16 + r) * 2048 + 1024 + h * 128 + fr * 8;
      const bf16x8 zz = *(const bf16x8*)yp;
      bf16x8 o;
#pragma unroll
      for (int e = 0; e < 4; ++e) { o[e] = (short)f2bf(lo[e] * bf2f((u16)zz[e])); o[4 + e] = (short)f2bf(hi[e] * bf2f((u16)zz[4 + e])); }
      *(bf16x8*)yp = o;
    }
  }
  __syncthreads();
}

__device__ __forceinline__ void phase_mix0(const Params& p, char* smem) {
  for (int tile = blockIdx.x; tile < 3072; tile += gridDim.x) {
    if (tile < 2048) attn_tile(p, tile, smem);
    else gmlp_tile(p, tile - 2048, smem);
  }
}

__device__ __forceinline__ float log_gamma_h(int h) { return log1pf(-exp2f(-5.f - (float)h)); }

__device__ __forceinline__ void pool_stage(const u16* PC, int mt, int g, int kt, int win, char* smem) {
  const int tid = threadIdx.x;
  const int c = (tid & 7) ^ ((tid >> 4) & 7);
#pragma unroll 1
  for (int ih = 0; ih < 2; ++ih) {
    const int r0 = ih * 64 + (tid >> 3);
    const int t0 = mt * 128 + r0;
    const u16* src = PC + (size_t)t0 * 1024 + g * 256 + kt * 64 + c * 8;
    float sum[2][8], inv[2];
    int cnt[2];
#pragma unroll
    for (int i = 0; i < 2; ++i) {
      cnt[i] = min(((t0 + i * 32) & (SEQ - 1)) + 1, win);
      inv[i] = 1.f / (float)cnt[i];
#pragma unroll
      for (int e = 0; e < 8; ++e) sum[i][e] = 0.f;
    }
#pragma unroll 1
    for (int q0 = 0; q0 < win; q0 += 4) {
      bf16x8 v[2][4];
#pragma unroll
      for (int i = 0; i < 2; ++i)
#pragma unroll
        for (int q = 0; q < 4; ++q) v[i][q] = *(const bf16x8*)(src + (size_t)(i * 32) * 1024 - (size_t)((q0 + q < cnt[i]) ? (q0 + q) : 0) * 1024);
#pragma unroll
      for (int i = 0; i < 2; ++i)
#pragma unroll
        for (int q = 0; q < 4; ++q) {
          const float wq = ((q0 + q < cnt[i]) ? inv[i] : 0.f) - ((q0 + q == 0) ? 1.f : 0.f);
#pragma unroll
          for (int e = 0; e < 8; ++e) sum[i][e] += wq * bf2f((u16)v[i][q][e]);
        }
    }
#pragma unroll
    for (int i = 0; i < 2; ++i) {
      bf16x8 o;
#pragma unroll
      for (int e = 0; e < 8; ++e) o[e] = (short)f2bf(sum[i][e]);
      *(bf16x8*)(smem + (r0 + i * 32) * 128 + (tid & 7) * 16) = o;
    }
  }
}

__device__ __forceinline__ void poolc_tile(const Params& p, int tile, char* smem) {
  const int mt = (tile >> 3) & 63 | ((tile >> 9) << 6), g = (tile < 512) ? ((tile >> 1) & 3) : (3 - ((tile >> 1) & 3)), nh = tile & 1;
  const int tid = threadIdx.x, lane = tid & 63, w = tid >> 6, fr = lane & 15, fq = lane >> 4;
  const u16* PC = (const u16*)(p.ws + OFF_PC);
  const u16* cwt = (const u16*)(p.ws + OFF_CWT) + (size_t)(g * 256 + nh * 128) * 256;
  u16* Yb = (u16*)(p.ws + OFF_Y);
  f32x4 acc[2][8]; zero_acc(acc);
  __syncthreads();
  for (int kt = 0; kt < 4; ++kt) {
    stage128x64(cwt + kt * 64, 256, smem + 16384);
    pool_stage(PC, mt, g, kt, 2 << g, smem);
    WAITV(0);
    __syncthreads();
    mma_ktile(smem, smem + 16384, acc);
    __syncthreads();
  }
  epi_rows(acc, smem, [&](int row, int col, const float (&v)[8]) {
    const int cc = g * 256 + nh * 128 + col;
    const f32x4 c0 = *(const f32x4*)(p.o_cscale + cc), c1 = *(const f32x4*)(p.o_cscale + cc + 4);
    u16* yp = Yb + ((size_t)mt * 128 + row) * 2048 + cc;
    const bf16x8 yy = *(const bf16x8*)yp;
    bf16x8 o;
#pragma unroll
    for (int e = 0; e < 4; ++e) { o[e] = (short)f2bf(v[e] * c0[e] * bf2f((u16)yy[e])); o[4 + e] = (short)f2bf(v[4 + e] * c1[e] * bf2f((u16)yy[4 + e])); }
    *(bf16x8*)yp = o;
  });
}

__device__ __forceinline__ void kvstate_tile(const Params& p, int tile, char* smem) {
  const int bh = tile >> 5, n = tile & 31, h = bh & 7, b = bh >> 3;
  const int tid = threadIdx.x;
  const u16* Kb = (const u16*)(p.ws + OFF_K); const u16* VTb = (const u16*)(p.ws + OFF_VT);
  u16* ST = (u16*)(p.ws + OFF_STATE);
  const float lg = log_gamma_h(h);
  f32x4 acc[2][8]; zero_acc(acc);
  __syncthreads();
  for (int kt = 0; kt < 2; ++kt) {
    stage128x64(VTb + ((size_t)bh * 128) * 4096 + n * 128 + kt * 64, 4096, smem);
    {
      const int s = tid >> 2, dseg = (tid & 3) * 32;
      const float dec = __expf(lg * (float)(127 - (kt * 64 + s)));
      const u16* src = Kb + ((size_t)b * SEQ + n * 128 + kt * 64 + s) * 1024 + h * 128 + dseg;
#pragma unroll
      for (int q = 0; q < 4; ++q) {
        bf16x8 v = *(const bf16x8*)(src + q * 8);
#pragma unroll
        for (int e = 0; e < 8; ++e) {
          const int d = dseg + q * 8 + e;
          *(u16*)(smem + 16384 + d * 128 + ((((s >> 3) ^ ((d >> 1) & 7))) * 16) + (s & 7) * 2) = f2bf(bf2f((u16)v[e]) * dec);
        }
      }
    }
    WAITV(0);
    __syncthreads();
    mma_ktile(smem, smem + 16384, acc);
    __syncthreads();
  }
  store_nat(acc, ST + (size_t)tile * 16384, 128, smem);
}

__device__ __forceinline__ void phase_scan(const Params& p) {
  uint2* ST = (uint2*)(p.ws + OFF_STATE);
  for (int idx = blockIdx.x * NTHREADS + threadIdx.x; idx < 32 * 4096; idx += gridDim.x * NTHREADS) {
    const int bh = idx >> 12, wi = idx & 4095, h = bh & 7;
    const float cd = __expf(log_gamma_h(h) * 128.f);
    uint2* ptr = ST + (size_t)bh * 32 * 4096 + wi;
    uint2 v[32];
#pragma unroll
    for (int n = 0; n < 32; ++n) v[n] = ptr[(size_t)n * 4096];
    float s0 = 0.f, s1 = 0.f, s2 = 0.f, s3 = 0.f;
#pragma unroll
    for (int n = 0; n < 32; ++n) {
      uint2 o;
      o.x = (unsigned)f2bf(s0) | ((unsigned)f2bf(s1) << 16);
      o.y = (unsigned)f2bf(s2) | ((unsigned)f2bf(s3) << 16);
      s0 = s0 * cd + bf2f((u16)(v[n].x & 0xffff)); s1 = s1 * cd + bf2f((u16)(v[n].x >> 16));
      s2 = s2 * cd + bf2f((u16)(v[n].y & 0xffff)); s3 = s3 * cd + bf2f((u16)(v[n].y >> 16));
      ptr[(size_t)n * 4096] = o;
    }
  }
}

__device__ __forceinline__ void retout_tile(const Params& p, int tile, char* smem) {
  const int bh = tile >> 5, n = tile & 31, h = bh & 7, b = bh >> 3;
  const int tid = threadIdx.x, lane = tid & 63, w = tid >> 6, fr = lane & 15, fq = lane >> 4;
  const u16* Qb = (const u16*)(p.ws + OFF_Q); const u16* Kb = (const u16*)(p.ws + OFF_K); const u16* VTb = (const u16*)(p.ws + OFF_VT);
  const u16* ST = (const u16*)(p.ws + OFF_STATE) + (size_t)tile * 16384;
  u16* Yb = (u16*)(p.ws + OFF_Y);
  const float lg = log_gamma_h(h);
  const size_t t0 = (size_t)b * SEQ + n * 128;
  const u16* Qt = Qb + t0 * 1024 + h * 128; const u16* Kt = Kb + t0 * 1024 + h * 128;
  char* sP = smem + 32768;
  f32x4 acc[2][8]; zero_acc(acc);
  __syncthreads();
#pragma unroll 1
  for (int kt = 0; kt < 2; ++kt) {
    stage128x64(Kt + kt * 64, 1024, smem); stage128x64(Qt + kt * 64, 1024, smem + 16384);
    WAITV(0); __syncthreads();
    mma_ktile(smem, smem + 16384, acc);
    __syncthreads();
  }
  {
    float cf[8];
#pragma unroll
    for (int nn = 0; nn < 8; ++nn) cf[nn] = __expf(lg * (float)(nn * 16 + fr));
#pragma unroll
    for (int m = 0; m < 2; ++m) {
      const int s0 = w * 32 + m * 16 + fq * 4;
      float rf[4];
#pragma unroll
      for (int j = 0; j < 4; ++j) rf[j] = __expf(-lg * (float)(s0 + j));
#pragma unroll
      for (int nn = 0; nn < 8; ++nn) {
        const int t = nn * 16 + fr;
        bf16x4 pk;
#pragma unroll
        for (int j = 0; j < 4; ++j) pk[j] = (short)f2bf((t >= s0 + j) ? acc[m][nn][j] * cf[nn] * rf[j] : 0.f);
        *(bf16x4*)(sP + (s0 >> 6) * 16384 + t * 128 + (((((s0 & 63) >> 3) ^ ((t >> 1) & 7))) * 16) + (s0 & 7) * 2) = pk;
      }
    }
  }
  zero_acc(acc);
#pragma unroll 1
  for (int kt = 0; kt < 2; ++kt) {
    stage128x64(Qt + kt * 64, 1024, smem); stage128x64(ST + kt * 64, 128, smem + 16384);
    WAITV(0); __syncthreads();
    mma_ktile(smem, smem + 16384, acc);
    __syncthreads();
  }
#pragma unroll
  for (int m = 0; m < 2; ++m)
#pragma unroll
    for (int j = 0; j < 4; ++j) {
      const float qd = __expf(lg * (float)(w * 32 + m * 16 + fq * 4 + j + 1));
#pragma unroll
      for (int nn = 0; nn < 8; ++nn) acc[m][nn][j] *= qd;
    }
#pragma unroll 1
  for (int kt = 0; kt < 2; ++kt) {
    stage128x64(VTb + ((size_t)bh * 128) * 4096 + n * 128 + kt * 64, 4096, smem + 16384);
    WAITV(0); __syncthreads();
    mma_ktile(sP + kt * 16384, smem + 16384, acc);
    __syncthreads();
  }
  float ss[2][4]; row_sumsq(acc, ss);
#pragma unroll
  for (int m = 0; m < 2; ++m)
#pragma unroll
    for (int j = 0; j < 4; ++j) {
      const float rstd = rsqrtf(ss[m][j] * (1.f / 128.f) + 1e-6f);
#pragma unroll
      for (int nn = 0; nn < 8; ++nn) acc[m][nn][j] *= rstd;
    }
  epi_rows(acc, smem, [&](int row, int col, const float (&v)[8]) {
    u16* yp = Yb + (t0 + row) * 2048 + 1024 + h * 128 + col;
    const bf16x8 yy = *(const bf16x8*)yp;
    bf16x8 o;
#pragma unroll
    for (int e = 0; e < 8; ++e) o[e] = (short)f2bf(v[e] * bf2f((u16)yy[e]));
    *(bf16x8*)yp = o;
  });
}

__device__ __forceinline__ void phase_mix1a(const Params& p, char* smem) {
  for (int tile = blockIdx.x; tile < 2048; tile += gridDim.x) {
    if (tile < 1024) poolc_tile(p, tile, smem);
    else kvstate_tile(p, tile - 1024, smem);
  }
}
__device__ __forceinline__ void phase_mix1b(const Params& p, char* smem) {
  for (int tile = blockIdx.x; tile < 1024; tile += gridDim.x) retout_tile(p, tile, smem);
}

#define XB_TMO      128
#define XB_XCNT(j)  (256  + 64 * (j))
#define XB_XSUB(j)  (1280 + 64 * (j))
#define XB_XGEN(j)  (2304 + 64 * (j))
#define XB_TOP      3328
#define XB_TOPGEN   3392
#define XCD_BAR_WORDS 3456
#define XB_SPIN_CAP (1u << 20)
__device__ __forceinline__ unsigned xb_ld(unsigned* p)              { return __hip_atomic_load(p, __ATOMIC_RELAXED, __HIP_MEMORY_SCOPE_AGENT); }
__device__ __forceinline__ unsigned xb_add(unsigned* p, unsigned v) { return __hip_atomic_fetch_add(p, v, __ATOMIC_RELAXED, __HIP_MEMORY_SCOPE_AGENT); }
__device__ __forceinline__ unsigned xb_xcc_id() { return (unsigned)__builtin_amdgcn_s_getreg((3 << 11) | 20) & 0xFu; }
#define XB_SPIN(cond, bar) do { unsigned _sp = 0; while (cond) { __builtin_amdgcn_s_sleep(1); \
    if ((++_sp & 255u) == 0u) { if (xb_ld(&(bar)[XB_TMO])) break; if (_sp > XB_SPIN_CAP) { atomicAdd(&(bar)[XB_TMO], 1u); break; } } } } while (0)
struct XcdBarrier { unsigned* bar; unsigned x, nloc, nx; };
__device__ __forceinline__ void xcd_barrier_complete(unsigned* bar, unsigned x, unsigned& nloc, unsigned& nx) {
  const unsigned G = gridDim.x;
  unsigned sum, cnt, mine, sp = 0u;
  for (;;) {
    sum = 0u; cnt = 0u; mine = 0u;
#pragma unroll
    for (unsigned j = 0; j < 16; ++j) { const unsigned c = xb_ld(&bar[XB_XCNT(j)]); sum += c; cnt += (c > 0u) ? 1u : 0u; mine = (j == x) ? c : mine; }
    if (sum == G) break;
    __builtin_amdgcn_s_sleep(1);
    if ((++sp & 255u) == 0u) { if (xb_ld(&bar[XB_TMO])) break; if (sp > XB_SPIN_CAP) { atomicAdd(&bar[XB_TMO], 1u); break; } }
  }
  nloc = mine > 0u ? mine : 1u; nx = cnt > 0u ? cnt : 1u;
}
__device__ __forceinline__ void xcd_barrier(XcdBarrier& b) {
  asm volatile("s_waitcnt vmcnt(0)" ::: "memory");
  __syncthreads();
  if (threadIdx.x == 0) {
    unsigned* bar = b.bar;
    __builtin_amdgcn_s_waitcnt(0);
    if (b.nloc == 0u) xcd_barrier_complete(bar, b.x, b.nloc, b.nx);
    const unsigned nloc = b.nloc, nx = b.nx;
    const unsigned old = xb_add(&bar[XB_XSUB(b.x)], 1u);
    const unsigned gen = old / nloc;
    if (old + 1u == (gen + 1u) * nloc) {
      __builtin_amdgcn_fence(__ATOMIC_RELEASE, "agent");
      asm volatile("s_waitcnt vmcnt(0)" ::: "memory");
      const unsigned og = xb_add(&bar[XB_TOP], 1u);
      const unsigned tg = og / nx;
      if (og + 1u == (tg + 1u) * nx) xb_add(&bar[XB_TOPGEN], 1u);
      else XB_SPIN(xb_ld(&bar[XB_TOPGEN]) == tg, bar);
      __builtin_amdgcn_fence(__ATOMIC_ACQUIRE, "agent");
      xb_add(&bar[XB_XGEN(b.x)], 1u);
      asm volatile("s_waitcnt vmcnt(0)" ::: "memory");
    } else {
      XB_SPIN(xb_ld(&bar[XB_XGEN(b.x)]) == gen, bar);
      __builtin_amdgcn_fence(__ATOMIC_ACQUIRE, "agent");
      asm volatile("s_waitcnt vmcnt(0)" ::: "memory");
    }
  }
  __syncthreads();
}

__global__ void __launch_bounds__(NTHREADS, 2) fwd_megakernel(Params p) {
  __shared__ __attribute__((aligned(16))) char smem[65536 + 16];
  cg::grid_group grid = cg::this_grid();
  XcdBarrier xb; xb.bar = (unsigned*)(p.ws + OFF_BAR); xb.x = xb_xcc_id(); xb.nloc = 0u; xb.nx = 0u;
  if (threadIdx.x == 0) (void)xb_add(&xb.bar[XB_XCNT(xb.x)], 1u);
  phase0(p, smem);
  if (p.ws == nullptr) grid.sync();
  xcd_barrier(xb);
  phase_hdn(p, 0, smem);
  xcd_barrier(xb);
  phase_inproj(p, 0, smem);
  xcd_barrier(xb);
  phase_mix0(p, smem);
  xcd_barrier(xb);
  phase_outproj(p, 0, smem);
  xcd_barrier(xb);
  phase_hdn(p, 1, smem);
  xcd_barrier(xb);
  phase_inproj(p, 1, smem);
  xcd_barrier(xb);
  phase_mix1a(p, smem);
  xcd_barrier(xb);
  phase_scan(p);
  xcd_barrier(xb);
  phase_mix1b(p, smem);
  xcd_barrier(xb);
  phase_outproj(p, 1, smem);
}

extern "C" void kernel_launch(void* const* d_in, const int* in_sizes, int n_in, void* d_out, int out_size, void* d_ws, size_t ws_size, hipStream_t stream) {
  static int grid_blocks = 0;
  if (!grid_blocks) {
    int dev = 0, cus = 0, per_cu = 0;
    hipGetDevice(&dev);
    hipDeviceGetAttribute(&cus, hipDeviceAttributeMultiprocessorCount, dev);
    hipOccupancyMaxActiveBlocksPerMultiprocessor(&per_cu, fwd_megakernel, NTHREADS, 0);
    if (per_cu > 2) per_cu = 2;
    if (per_cu < 1) per_cu = 1;
    grid_blocks = cus * per_cu;
    if (ws_size < WS_NEED || n_in != 22) { fprintf(stderr, "kernel_launch: ws_size %zu < %zu or n_in %d != 22\n", ws_size, (size_t)WS_NEED, n_in); grid_blocks = -1; }
  }
  if (grid_blocks < 0) return;
  Params p{};
  p.x = (const float*)d_in[0]; p.c = (const float*)d_in[1]; p.pos = (const int*)d_in[2];
  p.e_norm_g = (const float*)d_in[3]; p.e_w_mod = (const float*)d_in[4]; p.e_b_mod = (const float*)d_in[5]; p.e_w_in = (const float*)d_in[6];
  p.e_vg = (const float*)d_in[7]; p.e_ws = (const float*)d_in[8]; p.e_bs = (const float*)d_in[9]; p.e_qg = (const float*)d_in[10]; p.e_kg = (const float*)d_in[11];
  p.e_w_out = (const float*)d_in[12];
  p.o_norm_g = (const float*)d_in[13]; p.o_w_mod = (const float*)d_in[14]; p.o_b_mod = (const float*)d_in[15]; p.o_w_in = (const float*)d_in[16];
  p.o_cw = (const float*)d_in[17]; p.o_cscale = (const float*)d_in[18]; p.o_qg = (const float*)d_in[19]; p.o_kg = (const float*)d_in[20]; p.o_w_out = (const float*)d_in[21];
  p.out = (float*)d_out; p.ws = (char*)d_ws;
  if (hipMemsetAsync((char*)d_ws + OFF_BAR, 0, 16384, stream) != hipSuccess) { fprintf(stderr, "kernel_launch: hipMemsetAsync of barrier words failed\n"); return; }
  void* args[] = {&p};
  hipError_t e = hipLaunchCooperativeKernel((void*)fwd_megakernel, dim3(grid_blocks), dim3(NTHREADS), args, 0, stream);
  if (e != hipSuccess) fprintf(stderr, "cooperative launch failed: %s (grid %d)\n", hipGetErrorString(e), grid_blocks);
}
```

```cpp
#include <hip/hip_runtime.h>
#include <hip/hip_cooperative_groups.h>
#include <cstdio>
namespace cg = cooperative_groups;

typedef unsigned short u16;
using bf16x8 = __attribute__((ext_vector_type(8))) short;
using bf16x4 = __attribute__((ext_vector_type(4))) short;
using f32x4  = __attribute__((ext_vector_type(4))) float;

#define NTHREADS 256
constexpr int TOK = 16384, DM = 1024, SEQ = 4096;
constexpr int EVEN_IN = 7168, ODD_IN = 6144;
constexpr size_t MiB = 1u << 20;
constexpr size_t OFF_WIN1T  = 0;
constexpr size_t OFF_WOUT1T = 12 * MiB;
constexpr size_t OFF_CWT    = 16 * MiB;
constexpr size_t OFF_WS     = 16 * MiB + 512 * 1024;
constexpr size_t OFF_MODP   = 16 * MiB + 768 * 1024;
constexpr size_t OFF_BAR    = 17 * MiB + 512 * 1024;
constexpr size_t OFF_ROPEC  = 18 * MiB;
constexpr size_t OFF_ROPES  = 22 * MiB;
constexpr size_t OFF_WIN0T  = 26 * MiB;
constexpr size_t OFF_WOUT0T = 40 * MiB;
constexpr size_t OFF_PC     = 26 * MiB;
constexpr size_t OFF_HDN    = 58 * MiB;
constexpr size_t OFF_STATE  = 58 * MiB;
constexpr size_t OFF_Y      = 90 * MiB;
constexpr size_t OFF_Q      = 154 * MiB;
constexpr size_t OFF_K      = 186 * MiB;
constexpr size_t OFF_VT     = 218 * MiB;
constexpr size_t WS_NEED    = 250 * MiB;
constexpr size_t OFF_U      = 0;
constexpr size_t OFF_VNT    = 32 * MiB;

struct Params {
  const float* x; const float* c; const int* pos;
  const float* e_norm_g; const float* e_w_mod; const float* e_b_mod; const float* e_w_in;
  const float* e_vg; const float* e_ws; const float* e_bs; const float* e_qg; const float* e_kg; const float* e_w_out;
  const float* o_norm_g; const float* o_w_mod; const float* o_b_mod; const float* o_w_in;
  const float* o_cw; const float* o_cscale; const float* o_qg; const float* o_kg; const float* o_w_out;
  float* out; char* ws;
};

__device__ __forceinline__ u16 f2bf(float f) {
  unsigned u = __float_as_uint(f);
  u += 0x7fffu + ((u >> 16) & 1u);
  return (u16)(u >> 16);
}
__device__ __forceinline__ float bf2f(u16 h) { return __uint_as_float(((unsigned)h) << 16); }
__device__ __forceinline__ float silu_f(float v) { return v / (1.f + __expf(-v)); }

#define WAITV(n) asm volatile("s_waitcnt vmcnt(" #n ")" ::: "memory")
#define BAR() __builtin_amdgcn_s_barrier()

__device__ __forceinline__ void glds16(const void* g, void* l) {
  __builtin_amdgcn_global_load_lds((const unsigned*)g, (__attribute__((address_space(3))) unsigned*)l, 16, 0, 0);
}

__device__ __forceinline__ void stage128x64(const u16* g, size_t ld, char* lds) {
  const int tid = threadIdx.x;
  const int c = (tid & 7) ^ ((tid >> 4) & 7);
  const u16* src = g + (size_t)(tid >> 3) * ld + c * 8;
  char* dst = lds + tid * 16;
#pragma unroll
  for (int i = 0; i < 4; ++i) glds16(src + (size_t)(i * 32) * ld, dst + i * 4096);
}

__device__ __forceinline__ void mma_ktile(const char* sA, const char* sB, f32x4 (&acc)[2][8]) {
  const int lane = threadIdx.x & 63, w = threadIdx.x >> 6, fr = lane & 15, fq = lane >> 4;
  const int sw = (fr >> 1) & 7;
#pragma unroll
  for (int ks = 0; ks < 2; ++ks) {
    const int cp = ((ks * 4 + fq) ^ sw) * 16;
    bf16x8 a[2], b[8];
#pragma unroll
    for (int m = 0; m < 2; ++m) a[m] = *(const bf16x8*)(sA + (w * 32 + m * 16 + fr) * 128 + cp);
#pragma unroll
    for (int n = 0; n < 8; ++n) b[n] = *(const bf16x8*)(sB + (n * 16 + fr) * 128 + cp);
#pragma unroll
    for (int m = 0; m < 2; ++m)
#pragma unroll
      for (int n = 0; n < 8; ++n)
        acc[m][n] = __builtin_amdgcn_mfma_f32_16x16x32_bf16(a[m], b[n], acc[m][n], 0, 0, 0);
  }
  __builtin_amdgcn_iglp_opt(1);
}

__device__ __forceinline__ void gemm_main(const u16* A, size_t lda, const u16* B, size_t ldb, int K, f32x4 (&acc)[2][8], char* smem) {
  const int nk = K >> 6;
  BAR();
  stage128x64(A, lda, smem);
  stage128x64(B, ldb, smem + 16384);
  for (int kt = 0; kt < nk; ++kt) {
    char* cur = smem + (kt & 1) * 32768;
    WAITV(0);
    BAR();
    if (kt + 1 < nk) {
      char* nxt = smem + ((kt + 1) & 1) * 32768;
      stage128x64(A + (kt + 1) * 64, lda, nxt);
      stage128x64(B + (kt + 1) * 64, ldb, nxt + 16384);
    }
    mma_ktile(cur, cur + 16384, acc);
  }
  BAR();
  asm volatile("" ::: "memory");
}

__device__ __forceinline__ void zero_acc(f32x4 (&acc)[2][8]) {
#pragma unroll
  for (int m = 0; m < 2; ++m)
#pragma unroll
    for (int n = 0; n < 8; ++n) acc[m][n] = f32x4{0.f, 0.f, 0.f, 0.f};
}

__device__ __forceinline__ void row_sumsq(const f32x4 (&acc)[2][8], float (&ss)[2][4]) {
#pragma unroll
  for (int m = 0; m < 2; ++m)
#pragma unroll
    for (int j = 0; j < 4; ++j) {
      float s = 0.f;
#pragma unroll
      for (int n = 0; n < 8; ++n) s += acc[m][n][j] * acc[m][n][j];
      s += __shfl_xor(s, 1); s += __shfl_xor(s, 2); s += __shfl_xor(s, 4); s += __shfl_xor(s, 8);
      ss[m][j] = s;
    }
}

template <class F>
__device__ __forceinline__ void epi_rows(const f32x4 (&acc)[2][8], char* slab, F f) {
  const int lane = threadIdx.x & 63, w = threadIdx.x >> 6, fr = lane & 15, fq = lane >> 4;
  float* st = (float*)slab + w * (16 * 128);
#pragma unroll
  for (int m = 0; m < 2; ++m) {
#pragma unroll
    for (int n = 0; n < 8; ++n)
#pragma unroll
      for (int j = 0; j < 4; ++j) st[(fq * 4 + j) * 128 + ((n * 16 + fr + 8 * fq) & 127)] = acc[m][n][j];
    asm volatile("" ::: "memory");
#pragma unroll
    for (int it = 0; it < 4; ++it) {
      const int r = it * 4 + fq;
      const float* rp = st + r * 128 + ((fr * 8 + 8 * it) & 127);
      const f32x4 lo = *(const f32x4*)rp, hi = *(const f32x4*)(rp + 4);
      float v[8] = {lo[0], lo[1], lo[2], lo[3], hi[0], hi[1], hi[2], hi[3]};
      f(w * 32 + m * 16 + r, fr * 8, v);
    }
    asm volatile("" ::: "memory");
  }
}
__device__ __forceinline__ bf16x8 pack8(const float (&v)[8]) {
  bf16x8 o;
#pragma unroll
  for (int e = 0; e < 8; ++e) o[e] = (short)f2bf(v[e]);
  return o;
}
__device__ __forceinline__ void store_nat(const f32x4 (&v)[2][8], u16* dst, size_t ld, char* smem) {
  epi_rows(v, smem, [&](int row, int col, const float (&x)[8]) { *(bf16x8*)(dst + (size_t)row * ld + col) = pack8(x); });
}
__device__ __forceinline__ void store_tr(const f32x4 (&v)[2][8], u16* dst, size_t ld, char* smem) {
  const int tid = threadIdx.x, lane = tid & 63, w = tid >> 6, fr = lane & 15, fq = lane >> 4;
#pragma unroll
  for (int m = 0; m < 2; ++m)
#pragma unroll
    for (int n = 0; n < 8; ++n) {
      bf16x4 pk;
#pragma unroll
      for (int j = 0; j < 4; ++j) pk[j] = (short)f2bf(v[m][n][j]);
      *(bf16x4*)(smem + (n * 16 + fr) * 272 + (w * 32 + m * 16 + fq * 4) * 2) = pk;
    }
  __syncthreads();
#pragma unroll
  for (int it = 0; it < 8; ++it) {
    const int idx = it * 256 + tid, col = idx >> 4, seg = idx & 15;
    *(bf16x8*)(dst + (size_t)col * ld + seg * 8) = *(const bf16x8*)(smem + col * 272 + seg * 16);
  }
}

__device__ __forceinline__ void transpose_job(const float* src, int R, int C, u16* dst, int tile, float* lds) {
  const int tc = C >> 6;
  const int r0 = (tile / tc) * 64, c0 = (tile % tc) * 64;
  const int tid = threadIdx.x;
#pragma unroll
  for (int i = 0; i < 4; ++i) {
    int r = (tid >> 4) + 16 * i, c4 = (tid & 15) * 4;
    float4 v = *(const float4*)(src + (size_t)(r0 + r) * C + c0 + c4);
    float* d = lds + r * 65 + c4;
    d[0] = v.x; d[1] = v.y; d[2] = v.z; d[3] = v.w;
  }
  __syncthreads();
  {
    int c = tid >> 2, rb = (tid & 3) * 16;
    bf16x8 o0, o1;
#pragma unroll
    for (int i = 0; i < 8; ++i) { o0[i] = (short)f2bf(lds[(rb + i) * 65 + c]); o1[i] = (short)f2bf(lds[(rb + 8 + i) * 65 + c]); }
    u16* d = dst + (size_t)(c0 + c) * R + r0 + rb;
    *(bf16x8*)d = o0; *(bf16x8*)(d + 8) = o1;
  }
  __syncthreads();
}

__device__ __forceinline__ void phase0(const Params& p, char* smem) {
  float* lds = (float*)smem;
  char* ws = p.ws;
  const int tid = threadIdx.x;
  constexpr int J_T0 = 1792, J_T1 = J_T0 + 512, J_T2 = J_T1 + 1536, J_T3 = J_T2 + 512, J_T4 = J_T3 + 64;
  constexpr int J_MOD = J_T4 + 768, J_ROPE = J_MOD + 1024, J_WS = J_ROPE + 128;
  for (int job0 = blockIdx.x; job0 < J_WS; job0 += gridDim.x) {
    const int job = (job0 < 768) ? (J_T4 + job0) : ((job0 - 768 < J_T4) ? (job0 - 768) : job0);
    if (job < J_T0)      transpose_job(p.e_w_in, 1024, EVEN_IN, (u16*)(ws + OFF_WIN0T), job, lds);
    else if (job < J_T1) transpose_job(p.e_w_out, 2048, 1024, (u16*)(ws + OFF_WOUT0T), job - J_T0, lds);
    else if (job < J_T2) transpose_job(p.o_w_in, 1024, ODD_IN, (u16*)(ws + OFF_WIN1T), job - J_T1, lds);
    else if (job < J_T3) transpose_job(p.o_w_out, 2048, 1024, (u16*)(ws + OFF_WOUT1T), job - J_T2, lds);
    else if (job < J_T4) { int q = job - J_T3, g = q >> 4; transpose_job(p.o_cw + (size_t)g * 65536, 256, 256, (u16*)(ws + OFF_CWT) + (size_t)g * 65536, q & 15, lds); }
    else if (job < J_MOD) {
      int q = job - J_T4; int layer = q / 384; q %= 384; int ks = q / 48, jb = q % 48;
      const float* wm = layer ? p.o_w_mod : p.e_w_mod; const float* bm = layer ? p.o_b_mod : p.e_b_mod;
      const int wv_ = tid >> 6, jl = tid & 63, j = jb * 64 + jl;
      __syncthreads();
      for (int i = tid; i < 512; i += NTHREADS) { int bb = i >> 7, kk = i & 127; lds[i] = silu_f(p.c[bb * 1024 + ks * 128 + kk]); }
      __syncthreads();
      float a0 = 0.f, a1 = 0.f, a2 = 0.f, a3 = 0.f;
      const float* wp = wm + (size_t)(ks * 128 + wv_ * 32) * 3072 + j;
      float wl[32];
#pragma unroll
      for (int k = 0; k < 32; ++k) wl[k] = wp[(size_t)k * 3072];
#pragma unroll
      for (int k = 0; k < 32; ++k) {
        const int kk = wv_ * 32 + k;
        a0 += lds[kk] * wl[k]; a1 += lds[128 + kk] * wl[k]; a2 += lds[256 + kk] * wl[k]; a3 += lds[384 + kk] * wl[k];
      }
      float* red = lds + 512;
      red[(wv_ * 4 + 0) * 64 + jl] = a0; red[(wv_ * 4 + 1) * 64 + jl] = a1; red[(wv_ * 4 + 2) * 64 + jl] = a2; red[(wv_ * 4 + 3) * 64 + jl] = a3;
      __syncthreads();
      {
        const int bb = tid >> 6;
        float r = red[(0 * 4 + bb) * 64 + jl] + red[(1 * 4 + bb) * 64 + jl] + red[(2 * 4 + bb) * 64 + jl] + red[(3 * 4 + bb) * 64 + jl];
        if (ks == 0) r += bm[j];
        ((float*)(ws + OFF_MODP))[(size_t)((layer * 8 + ks) * 4 + bb) * 3072 + j] = r;
      }
      __syncthreads();
    } else if (job < J_ROPE) {
      int q = job - J_MOD;
      float* rc = (float*)(ws + OFF_ROPEC); float* rs = (float*)(ws + OFF_ROPES);
#pragma unroll
      for (int i = 0; i < 4; ++i) {
        int e = q * 1024 + i * 256 + tid; int t = e >> 6, j = e & 63;
        float invf = (float)exp2(-(double)j * (13.287712379549449 / 64.0));
        float ang = (float)p.pos[t] * invf;
        double rev = (double)ang * 0.15915494309189535;
        float fr = (float)(rev - rint(rev));
        rc[e] = __builtin_amdgcn_cosf(fr); rs[e] = __builtin_amdgcn_sinf(fr);
      }
    } else {
      int q = job - J_ROPE;
      u16* wsb = (u16*)(ws + OFF_WS);
#pragma unroll
      for (int i = 0; i < 4; ++i) {
        int e = q * 1024 + i * 256 + tid; int t = (e >> 7) & 127, s = e & 127;
        wsb[e] = (s <= t) ? f2bf(p.e_ws[e]) : (u16)0;
      }
    }
  }
}

__device__ __forceinline__ void phase_hdn(const Params& p, int layer, char* smem) {
  const float* xin = layer ? p.out : p.x;
  const float* ng = layer ? p.o_norm_g : p.e_norm_g;
  const float* modp = (const float*)(p.ws + OFF_MODP) + (size_t)layer * 8 * 4 * 3072;
  u16* hdn = (u16*)(p.ws + OFF_HDN);
  float* mul = (float*)smem; float* add = mul + 1024;
  const int tid = threadIdx.x, lane = tid & 63, w = tid >> 6;
  for (int chunk = blockIdx.x; chunk < 512; chunk += gridDim.x) {
    const int b = chunk >> 7;
    __syncthreads();
    for (int k = tid; k < 1024; k += NTHREADS) {
      float sh = 0.f, sc = 0.f;
#pragma unroll
      for (int ks = 0; ks < 8; ++ks) { const float* mp = modp + (size_t)(ks * 4 + b) * 3072; sh += mp[k]; sc += mp[1024 + k]; }
      mul[k] = ng[k] * (1.f + sc); add[k] = sh;
    }
    __syncthreads();
    for (int r = 0; r < 8; r += 4) {
      const int t = chunk * 32 + w * 8 + r;
      float4 v[4][4]; float ss[4];
#pragma unroll
      for (int u = 0; u < 4; ++u) {
        const float* xr = xin + (size_t)(t + u) * 1024;
#pragma unroll
        for (int i = 0; i < 4; ++i) v[u][i] = *(const float4*)(xr + i * 256 + lane * 4);
      }
#pragma unroll
      for (int u = 0; u < 4; ++u) {
        float a = 0.f;
#pragma unroll
        for (int i = 0; i < 4; ++i) a += v[u][i].x * v[u][i].x + v[u][i].y * v[u][i].y + v[u][i].z * v[u][i].z + v[u][i].w * v[u][i].w;
#pragma unroll
        for (int o = 1; o < 64; o <<= 1) a += __shfl_xor(a, o);
        ss[u] = rsqrtf(a * (1.f / 1024.f) + 1e-6f);
      }
#pragma unroll
      for (int i = 0; i < 4; ++i) {
        const int k = i * 256 + lane * 4;
        const float4 mu = *(const float4*)(mul + k), ad = *(const float4*)(add + k);
#pragma unroll
        for (int u = 0; u < 4; ++u) {
          bf16x4 o;
          o[0] = (short)f2bf(v[u][i].x * ss[u] * mu.x + ad.x);
          o[1] = (short)f2bf(v[u][i].y * ss[u] * mu.y + ad.y);
          o[2] = (short)f2bf(v[u][i].z * ss[u] * mu.z + ad.z);
          o[3] = (short)f2bf(v[u][i].w * ss[u] * mu.w + ad.w);
          *(bf16x4*)(hdn + (size_t)(t + u) * 1024 + k) = o;
        }
      }
    }
  }
}

__device__ __forceinline__ void phase_inproj(const Params& p, int layer, char* smem) {
  const int NT = layer ? 48 : 56;
  const u16* hdn = (const u16*)(p.ws + OFF_HDN);
  const u16* wt = (const u16*)(p.ws + (layer ? OFF_WIN1T : OFF_WIN0T));
  u16* Yb = (u16*)(p.ws + OFF_Y); u16* Qb = (u16*)(p.ws + OFF_Q); u16* Kb = (u16*)(p.ws + OFF_K); u16* VTb = (u16*)(p.ws + OFF_VT);
  const int lane = threadIdx.x & 63, w = threadIdx.x >> 6, fr = lane & 15, fq = lane >> 4;
  const int ntiles = 128 * NT;
  for (int tile = blockIdx.x; tile < ntiles; tile += gridDim.x) {
    const int sup = (tile & 7) + 8 * (tile / 512), within = (tile >> 3) & 63;
    const int nsn = NT / 8;
    const int mt = (sup / nsn) * 8 + (within & 7), nt = (sup % nsn) * 8 + (within >> 3);
    f32x4 acc[2][8]; zero_acc(acc);
    gemm_main(hdn + (size_t)mt * 128 * 1024, 1024, wt + (size_t)nt * 128 * 1024, 1024, 1024, acc, smem);
    const int kind = nt >> 3, sub = nt & 7;
    const size_t t0 = (size_t)mt * 128;
    const int zk = layer ? 4 : 5;
    u16* dst; size_t ld; bool tr = false;
    if (kind >= zk) {
#pragma unroll
      for (int m = 0; m < 2; ++m)
#pragma unroll
        for (int n = 0; n < 8; ++n)
#pragma unroll
          for (int j = 0; j < 4; ++j) acc[m][n][j] = silu_f(acc[m][n][j]);
      dst = Yb + t0 * 2048 + (nt - zk * 8) * 128; ld = 2048;
    } else if (kind == zk - 1) {
      const int b = mt >> 5, s0 = (mt & 31) * 128;
      dst = VTb + ((size_t)(b * 8 + sub) * 128) * 4096 + s0; ld = 4096; tr = true;
    } else if (kind == 0) {
      dst = (layer == 0 ? (u16*)((char*)p.out + OFF_U) : (u16*)(p.ws + OFF_PC)) + t0 * 1024 + sub * 128; ld = 1024;
    } else {
      const bool isv = (layer == 0 && kind == 1);
      const bool isq = (layer == 0) ? (kind == 2) : (kind == 1);
      const float* gn = isv ? (p.e_vg + sub * 128) : ((layer == 0) ? (isq ? p.e_qg : p.e_kg) : (isq ? p.o_qg : p.o_kg));
      const float fold = isv ? 1.f : (((layer == 0) == isq) ? (layer == 0 ? 0.08838834764831845f * 1.4426950408889634f : 0.08838834764831845f) : 1.f);
      float ss[2][4]; row_sumsq(acc, ss);
      float gv[8];
#pragma unroll
      for (int n = 0; n < 8; ++n) gv[n] = gn[n * 16 + fr];
#pragma unroll
      for (int m = 0; m < 2; ++m)
#pragma unroll
        for (int j = 0; j < 4; ++j) {
          const float rstd = rsqrtf(ss[m][j] * (1.f / 128.f) + 1e-6f);
#pragma unroll
          for (int n = 0; n < 8; ++n) acc[m][n][j] *= rstd * gv[n];
        }
      if (layer == 1) {
        const float* rc = (const float*)(p.ws + OFF_ROPEC); const float* rs = (const float*)(p.ws + OFF_ROPES);
#pragma unroll
        for (int m = 0; m < 2; ++m)
#pragma unroll
          for (int j = 0; j < 4; ++j) {
            const size_t t = t0 + w * 32 + m * 16 + fq * 4 + j;
#pragma unroll
            for (int n = 0; n < 4; ++n) {
              const float cs = rc[t * 64 + n * 16 + fr], sn = rs[t * 64 + n * 16 + fr];
              const float x1 = acc[m][n][j], x2 = acc[m][n + 4][j];
              acc[m][n][j] = (x1 * cs - x2 * sn) * fold; acc[m][n + 4][j] = (x1 * sn + x2 * cs) * fold;
            }
            __builtin_amdgcn_sched_barrier(0);
          }
      } else if (fold != 1.f) {
#pragma unroll
        for (int m = 0; m < 2; ++m)
#pragma unroll
          for (int n = 0; n < 8; ++n) acc[m][n] *= fold;
      }
      if (isv) { dst = (u16*)((char*)p.out + OFF_VNT) + (size_t)(mt * 8 + sub) * 16384; ld = 128; tr = true; }
      else { dst = (isq ? Qb : Kb) + t0 * 1024 + sub * 128; ld = 1024; }
    }
    __builtin_amdgcn_sched_barrier(0);
    if (tr) store_tr(acc, dst, ld, smem); else store_nat(acc, dst, ld, smem);
  }
}

__device__ __forceinline__ void phase_outproj(const Params& p, int layer, char* smem) {
  const u16* Yb = (const u16*)(p.ws + OFF_Y);
  const u16* wt = (const u16*)(p.ws + (layer ? OFF_WOUT1T : OFF_WOUT0T));
  const float* xin = layer ? p.out : p.x;
  const float* modp = (const float*)(p.ws + OFF_MODP) + (size_t)layer * 8 * 4 * 3072;
  const int lane = threadIdx.x & 63, w = threadIdx.x >> 6, fr = lane & 15, fq = lane >> 4;
  for (int tile = blockIdx.x; tile < 1024; tile += gridDim.x) {
    const int sup = (tile & 7) + 8 * (tile / 512), within = (tile >> 3) & 63;
    const int mt = sup * 8 + (within & 7), nt = within >> 3;
    f32x4 acc[2][8]; zero_acc(acc);
    gemm_main(Yb + (size_t)mt * 128 * 2048, 2048, wt + (size_t)nt * 128 * 2048, 2048, 2048, acc, smem);
    const int b = mt >> 5;
    float gate[8];
    {
      f32x4 g0 = {0.f, 0.f, 0.f, 0.f}, g1 = {0.f, 0.f, 0.f, 0.f};
#pragma unroll
      for (int ks = 0; ks < 8; ++ks) {
        const float* gp = modp + (size_t)(ks * 4 + b) * 3072 + 2048 + nt * 128 + fr * 8;
        g0 += *(const f32x4*)gp; g1 += *(const f32x4*)(gp + 4);
      }
#pragma unroll
      for (int e = 0; e < 4; ++e) { gate[e] = g0[e]; gate[4 + e] = g1[e]; }
    }
    epi_rows(acc, smem, [&](int row, int col, const float (&v)[8]) {
      const size_t o = ((size_t)mt * 128 + row) * 1024 + nt * 128 + col;
      const f32x4 x0 = *(const f32x4*)(xin + o), x1 = *(const f32x4*)(xin + o + 4);
      f32x4 r0, r1;
#pragma unroll
      for (int e = 0; e < 4; ++e) { r0[e] = x0[e] + gate[e] * v[e]; r1[e] = x1[e] + gate[4 + e] * v[4 + e]; }
      *(f32x4*)(p.out + o) = r0; *(f32x4*)(p.out + o + 4) = r1;
    });
  }
}

__device__ __forceinline__ void gmlp_tile(const Params& p, int tile, char* smem) {
  const int chunk = tile >> 3, g = tile & 7;
  const int lane = threadIdx.x & 63, w = threadIdx.x >> 6, fr = lane & 15, fq = lane >> 4;
  f32x4 acc[2][8]; zero_acc(acc);
  gemm_main((const u16*)(p.ws + OFF_WS) + (size_t)g * 16384, 128, (const u16*)((char*)p.out + OFF_VNT) + (size_t)tile * 16384, 128, 128, acc, smem);
  const u16* U = (const u16*)((char*)p.out + OFF_U);
  u16* Yb = (u16*)(p.ws + OFF_Y);
  epi_rows(acc, smem, [&](int row, int col, const float (&v)[8]) {
    const float bs = p.e_bs[g * 128 + row];
    const size_t t = (size_t)chunk * 128 + row;
    const bf16x8 uu = *(const bf16x8*)(U + t * 1024 + g * 128 + col);
    u16* yp = Yb + t * 2048 + g * 128 + col;
    const bf16x8 yy = *(const bf16x8*)yp;
    bf16x8 o;
#pragma unroll
    for (int e = 0; e < 8; ++e) o[e] = (short)f2bf((v[e] + bs) * bf2f((u16)uu[e]) * bf2f((u16)yy[e]));
    *(bf16x8*)yp = o;
  });
}

__device__ __forceinline__ void attn_tile(const Params& p, int tile, char* smem) {
  const int qb = 63 - (tile & 63), h = (tile >> 6) & 7, b = tile >> 9;
  const int tid = threadIdx.x, lane = tid & 63, w = tid >> 6, fr = lane & 15, fq = lane >> 4;
  const u16* Qb = (const u16*)(p.ws + OFF_Q); const u16* Kb = (const u16*)(p.ws + OFF_K); const u16* VTb = (const u16*)(p.ws + OFF_VT);
  u16* Yb = (u16*)(p.ws + OFF_Y);
  const int q0 = qb * 64;
  const size_t tb = (size_t)b * SEQ;
  float* red = (float*)(smem + 65536);
  const int t = q0 + w * 16 + fr;
  bf16x8 qf[4];
#pragma unroll
  for (int ks = 0; ks < 4; ++ks) qf[ks] = *(const bf16x8*)(Qb + (tb + t) * 1024 + h * 128 + ks * 32 + fq * 8);
  f32x4 O[8];
#pragma unroll
  for (int md = 0; md < 8; ++md) O[md] = f32x4{0.f, 0.f, 0.f, 0.f};
  float carry = 0.f;
  auto stage_kv = [&](int kt_, char* buf) {
    const int key0_ = kt_ * 64;
    const int c = (tid & 15) ^ ((tid >> 4) & 15);
    const u16* src = Kb + (tb + key0_ + (tid >> 4)) * 1024 + h * 128 + c * 8;
#pragma unroll
    for (int i = 0; i < 4; ++i) glds16(src + (size_t)(i * 16) * 1024, buf + i * 4096 + tid * 16);
    stage128x64(VTb + ((size_t)(b * 8 + h) * 128) * 4096 + key0_, 4096, buf + 16384);
  };
  __syncthreads();
  stage_kv(qb, smem);
  WAITV(0);
  __syncthreads();
  for (int kt = qb; kt >= 0; --kt) {
    const int key0 = kt * 64;
    char* sK = smem + ((qb - kt) & 1) * 32768; char* sV = sK + 16384;
    if (kt > 0) stage_kv(kt - 1, smem + ((qb - kt + 1) & 1) * 32768);
    {
      f32x4 S[4];
#pragma unroll
      for (int m = 0; m < 4; ++m) S[m] = f32x4{0.f, 0.f, 0.f, 0.f};
#pragma unroll
      for (int ks = 0; ks < 4; ++ks)
#pragma unroll
        for (int m = 0; m < 4; ++m) {
          const bf16x8 kf = *(const bf16x8*)(sK + (m * 16 + fr) * 256 + (((ks * 4 + fq) ^ fr) * 16));
          S[m] = __builtin_amdgcn_mfma_f32_16x16x32_bf16(kf, qf[ks], S[m], 0, 0, 0);
        }
      float run = carry;
      float wv[4][4];
#pragma unroll
      for (int m = 3; m >= 0; --m) {
        float a[4];
        float gs = 0.f;
#pragma unroll
        for (int j = 0; j < 4; ++j) {
          const int s = key0 + m * 16 + fq * 4 + j;
          const float z = S[m][j];
          const float sp = fmaxf(z, 0.f) + __builtin_amdgcn_logf(1.f + __builtin_amdgcn_exp2f(-fabsf(z)));
          a[j] = (s < t) ? -sp : 0.f;
          gs += a[j];
        }
        const float v1 = __shfl_xor(gs, 16), v2 = __shfl_xor(gs, 32), v3 = __shfl_xor(v1, 32);
        const float tot = gs + v1 + v2 + v3;
        const float above = (((fq ^ 1) > fq) ? v1 : 0.f) + (((fq ^ 2) > fq) ? v2 : 0.f) + (((fq ^ 3) > fq) ? v3 : 0.f);
        const float base = run + above;
        float suf = 0.f;
#pragma unroll
        for (int j = 3; j >= 0; --j) {
          const bool valid = (key0 + m * 16 + fq * 4 + j) < t;
          wv[m][j] = valid ? __builtin_amdgcn_exp2f(S[m][j] + a[j] + base + suf) : 0.f;
          suf += a[j];
        }
        run += tot;
      }
      carry = run;
      bf16x8 pf[2];
#pragma unroll
      for (int c = 0; c < 2; ++c)
#pragma unroll
        for (int j = 0; j < 4; ++j) { pf[c][j] = (short)f2bf(wv[2 * c][j]); pf[c][4 + j] = (short)f2bf(wv[2 * c + 1][j]); }
#pragma unroll
      for (int c = 0; c < 2; ++c)
#pragma unroll
        for (int md = 0; md < 8; ++md) {
          const char* rowp = sV + (md * 16 + fr) * 128;
          const int sw = (fr >> 1) & 7;
          const int qa = 8 * c + fq, qb2 = qa + 4;
          const bf16x4 lo = *(const bf16x4*)(rowp + (((qa >> 1) ^ sw) * 16) + (qa & 1) * 8);
          const bf16x4 hi = *(const bf16x4*)(rowp + (((qb2 >> 1) ^ sw) * 16) + (qb2 & 1) * 8);
          bf16x8 vf;
          vf[0] = lo[0]; vf[1] = lo[1]; vf[2] = lo[2]; vf[3] = lo[3]; vf[4] = hi[0]; vf[5] = hi[1]; vf[6] = hi[2]; vf[7] = hi[3];
          O[md] = __builtin_amdgcn_mfma_f32_16x16x32_bf16(vf, pf[c], O[md], 0, 0, 0);
        }
    }
    float cm = carry;
#pragma unroll
    for (int o = 1; o < 16; o <<= 1) cm = fmaxf(cm, __shfl_xor(cm, o));
    if (lane == 0) red[w] = cm;
    WAITV(0);
    __syncthreads();
    const float allmax = fmaxf(fmaxf(red[0], red[1]), fmaxf(red[2], red[3]));
    if (allmax < -160.f) break;
  }
  {
    float* st = (float*)smem + w * (16 * 132);
#pragma unroll
    for (int md = 0; md < 8; ++md) *(f32x4*)(st + fr * 132 + md * 16 + fq * 4) = O[md];
#pragma unroll
    for (int it = 0; it < 4; ++it) {
      const int r = it * 4 + fq;
      const float* rp = st + r * 132 + fr * 8;
      const f32x4 lo = *(const f32x4*)rp, hi = *(const f32x4*)(rp + 4);
      u16* yp = Yb + (tb + q0 + w * 16 + r) * 2048 + 1024 + h * 128 + fr * 8;
      const bf16x8 zz = *(const bf16x8*)yp;
      bf16x8 o;
#pragma unroll
      for (int e = 0; e < 4; ++e) { o[e] = (short)f2bf(lo[e] * bf2f((u16)zz[e])); o[4 + e] = (short)f2bf(hi[e] * bf2f((u16)zz[4 + e])); }
      *(bf16x8*)yp = o;
    }
  }
  __syncthreads();
}

__device__ __forceinline__ void phase_mix0(const Params& p, char* smem) {
  for (int tile = blockIdx.x; tile < 3072; tile += gridDim.x) {
    if (tile < 2048) attn_tile(p, tile, smem);
    else gmlp_tile(p, tile - 2048, smem);
  }
}

__device__ __forceinline__ float log_gamma_h(int h) { return log1pf(-exp2f(-5.f - (float)h)); }

__device__ __forceinline__ void pool_stage(const u16* PC, int mt, int g, int kt, int win, char* smem) {
  const int tid = threadIdx.x;
  const int c = (tid & 7) ^ ((tid >> 4) & 7);
#pragma unroll 1
  for (int ih = 0; ih < 2; ++ih) {
    const int r0 = ih * 64 + (tid >> 3);
    const int t0 = mt * 128 + r0;
    const u16* src = PC + (size_t)t0 * 1024 + g * 256 + kt * 64 + c * 8;
    float sum[2][8], inv[2];
    int cnt[2];
#pragma unroll
    for (int i = 0; i < 2; ++i) {
      cnt[i] = min(((t0 + i * 32) & (SEQ - 1)) + 1, win);
      inv[i] = 1.f / (float)cnt[i];
#pragma unroll
      for (int e = 0; e < 8; ++e) sum[i][e] = 0.f;
    }
#pragma unroll 1
    for (int q0 = 0; q0 < win; q0 += 4) {
      bf16x8 v[2][4];
#pragma unroll
      for (int i = 0; i < 2; ++i)
#pragma unroll
        for (int q = 0; q < 4; ++q) v[i][q] = *(const bf16x8*)(src + (size_t)(i * 32) * 1024 - (size_t)((q0 + q < cnt[i]) ? (q0 + q) : 0) * 1024);
#pragma unroll
      for (int i = 0; i < 2; ++i)
#pragma unroll
        for (int q = 0; q < 4; ++q) {
          const float wq = ((q0 + q < cnt[i]) ? inv[i] : 0.f) - ((q0 + q == 0) ? 1.f : 0.f);
#pragma unroll
          for (int e = 0; e < 8; ++e) sum[i][e] += wq * bf2f((u16)v[i][q][e]);
        }
    }
#pragma unroll
    for (int i = 0; i < 2; ++i) {
      bf16x8 o;
#pragma unroll
      for (int e = 0; e < 8; ++e) o[e] = (short)f2bf(sum[i][e]);
      *(bf16x8*)(smem + (r0 + i * 32) * 128 + (tid & 7) * 16) = o;
    }
  }
}

__device__ __forceinline__ void poolc_tile(const Params& p, int tile, char* smem) {
  const int mt = (tile >> 3) & 63 | ((tile >> 9) << 6), g = (tile < 512) ? ((tile >> 1) & 3) : (3 - ((tile >> 1) & 3)), nh = tile & 1;
  const int tid = threadIdx.x, lane = tid & 63, w = tid >> 6, fr = lane & 15, fq = lane >> 4;
  const u16* PC = (const u16*)(p.ws + OFF_PC);
  const u16* cwt = (const u16*)(p.ws + OFF_CWT) + (size_t)(g * 256 + nh * 128) * 256;
  u16* Yb = (u16*)(p.ws + OFF_Y);
  f32x4 acc[2][8]; zero_acc(acc);
  __syncthreads();
  for (int kt = 0; kt < 4; ++kt) {
    stage128x64(cwt + kt * 64, 256, smem + 16384);
    pool_stage(PC, mt, g, kt, 2 << g, smem);
    WAITV(0);
    __syncthreads();
    mma_ktile(smem, smem + 16384, acc);
    __syncthreads();
  }
  epi_rows(acc, smem, [&](int row, int col, const float (&v)[8]) {
    const int cc = g * 256 + nh * 128 + col;
    const f32x4 c0 = *(const f32x4*)(p.o_cscale + cc), c1 = *(const f32x4*)(p.o_cscale + cc + 4);
    u16* yp = Yb + ((size_t)mt * 128 + row) * 2048 + cc;
    const bf16x8 yy = *(const bf16x8*)yp;
    bf16x8 o;
#pragma unroll
    for (int e = 0; e < 4; ++e) { o[e] = (short)f2bf(v[e] * c0[e] * bf2f((u16)yy[e])); o[4 + e] = (short)f2bf(v[4 + e] * c1[e] * bf2f((u16)yy[4 + e])); }
    *(bf16x8*)yp = o;
  });
}

__device__ __forceinline__ void kvstate_tile(const Params& p, int tile, char* smem) {
  const int bh = tile >> 5, n = tile & 31, h = bh & 7, b = bh >> 3;
  const int tid = threadIdx.x;
  const u16* Kb = (const u16*)(p.ws + OFF_K); const u16* VTb = (const u16*)(p.ws + OFF_VT);
  u16* ST = (u16*)(p.ws + OFF_STATE);
  const float lg = log_gamma_h(h);
  f32x4 acc[2][8]; zero_acc(acc);
  __syncthreads();
  for (int kt = 0; kt < 2; ++kt) {
    stage128x64(VTb + ((size_t)bh * 128) * 4096 + n * 128 + kt * 64, 4096, smem);
    {
      const int s = tid >> 2, dseg = (tid & 3) * 32;
      const float dec = __expf(lg * (float)(127 - (kt * 64 + s)));
      const u16* src = Kb + ((size_t)b * SEQ + n * 128 + kt * 64 + s) * 1024 + h * 128 + dseg;
#pragma unroll
      for (int q = 0; q < 4; ++q) {
        bf16x8 v = *(const bf16x8*)(src + q * 8);
#pragma unroll
        for (int e = 0; e < 8; ++e) {
          const int d = dseg + q * 8 + e;
          *(u16*)(smem + 16384 + d * 128 + ((((s >> 3) ^ ((d >> 1) & 7))) * 16) + (s & 7) * 2) = f2bf(bf2f((u16)v[e]) * dec);
        }
      }
    }
    WAITV(0);
    __syncthreads();
    mma_ktile(smem, smem + 16384, acc);
    __syncthreads();
  }
  store_nat(acc, ST + (size_t)tile * 16384, 128, smem);
}

__device__ __forceinline__ void phase_scan(const Params& p) {
  unsigned* ST = (unsigned*)(p.ws + OFF_STATE);
  for (int idx = blockIdx.x * NTHREADS + threadIdx.x; idx < 32 * 8192; idx += gridDim.x * NTHREADS) {
    const int bh = idx >> 13, wi = idx & 8191, h = bh & 7;
    const float cd = __expf(log_gamma_h(h) * 128.f);
    unsigned* ptr = ST + (size_t)bh * 32 * 8192 + wi;
    unsigned v[32];
#pragma unroll
    for (int n = 0; n < 32; ++n) v[n] = ptr[(size_t)n * 8192];
    float s0 = 0.f, s1 = 0.f;
#pragma unroll
    for (int n = 0; n < 32; ++n) {
      const unsigned o = (unsigned)f2bf(s0) | ((unsigned)f2bf(s1) << 16);
      s0 = s0 * cd + bf2f((u16)(v[n] & 0xffff)); s1 = s1 * cd + bf2f((u16)(v[n] >> 16));
      ptr[(size_t)n * 8192] = o;
    }
  }
}

__device__ __forceinline__ void retout_tile(const Params& p, int tile, char* smem) {
  const int bh = tile >> 5, n = tile & 31, h = bh & 7, b = bh >> 3;
  const int tid = threadIdx.x, lane = tid & 63, w = tid >> 6, fr = lane & 15, fq = lane >> 4;
  const u16* Qb = (const u16*)(p.ws + OFF_Q); const u16* Kb = (const u16*)(p.ws + OFF_K); const u16* VTb = (const u16*)(p.ws + OFF_VT);
  const u16* ST = (const u16*)(p.ws + OFF_STATE) + (size_t)tile * 16384;
  u16* Yb = (u16*)(p.ws + OFF_Y);
  const float lg = log_gamma_h(h);
  const size_t t0 = (size_t)b * SEQ + n * 128;
  const u16* Qt = Qb + t0 * 1024 + h * 128; const u16* Kt = Kb + t0 * 1024 + h * 128;
  char* sP = smem + 32768;
  f32x4 acc[2][8]; zero_acc(acc);
  __syncthreads();
#pragma unroll 1
  for (int kt = 0; kt < 2; ++kt) {
    stage128x64(Kt + kt * 64, 1024, smem); stage128x64(Qt + kt * 64, 1024, smem + 16384);
    WAITV(0); __syncthreads();
    mma_ktile(smem, smem + 16384, acc);
    __syncthreads();
  }
  {
    float cf[8];
#pragma unroll
    for (int nn = 0; nn < 8; ++nn) cf[nn] = __expf(lg * (float)(nn * 16 + fr));
#pragma unroll
    for (int m = 0; m < 2; ++m) {
      const int s0 = w * 32 + m * 16 + fq * 4;
      float rf[4];
#pragma unroll
      for (int j = 0; j < 4; ++j) rf[j] = __expf(-lg * (float)(s0 + j));
#pragma unroll
      for (int nn = 0; nn < 8; ++nn) {
        const int t = nn * 16 + fr;
        bf16x4 pk;
#pragma unroll
        for (int j = 0; j < 4; ++j) pk[j] = (short)f2bf((t >= s0 + j) ? acc[m][nn][j] * cf[nn] * rf[j] : 0.f);
        *(bf16x4*)(sP + (s0 >> 6) * 16384 + t * 128 + (((((s0 & 63) >> 3) ^ ((t >> 1) & 7))) * 16) + (s0 & 7) * 2) = pk;
      }
    }
  }
  zero_acc(acc);
#pragma unroll 1
  for (int kt = 0; kt < 2; ++kt) {
    stage128x64(Qt + kt * 64, 1024, smem); stage128x64(ST + kt * 64, 128, smem + 16384);
    WAITV(0); __syncthreads();
    mma_ktile(smem, smem + 16384, acc);
    __syncthreads();
  }
#pragma unroll
  for (int m = 0; m < 2; ++m)
#pragma unroll
    for (int j = 0; j < 4; ++j) {
      const float qd = __expf(lg * (float)(w * 32 + m * 16 + fq * 4 + j + 1));
#pragma unroll
      for (int nn = 0; nn < 8; ++nn) acc[m][nn][j] *= qd;
    }
#pragma unroll 1
  for (int kt = 0; kt < 2; ++kt) {
    stage128x64(VTb + ((size_t)bh * 128) * 4096 + n * 128 + kt * 64, 4096, smem + 16384);
    WAITV(0); __syncthreads();
    mma_ktile(sP + kt * 16384, smem + 16384, acc);
    __syncthreads();
  }
  float ss[2][4]; row_sumsq(acc, ss);
#pragma unroll
  for (int m = 0; m < 2; ++m)
#pragma unroll
    for (int j = 0; j < 4; ++j) {
      const float rstd = rsqrtf(ss[m][j] * (1.f / 128.f) + 1e-6f);
#pragma unroll
      for (int nn = 0; nn < 8; ++nn) acc[m][nn][j] *= rstd;
    }
  epi_rows(acc, smem, [&](int row, int col, const float (&v)[8]) {
    u16* yp = Yb + (t0 + row) * 2048 + 1024 + h * 128 + col;
    const bf16x8 yy = *(const bf16x8*)yp;
    bf16x8 o;
#pragma unroll
    for (int e = 0; e < 8; ++e) o[e] = (short)f2bf(v[e] * bf2f((u16)yy[e]));
    *(bf16x8*)yp = o;
  });
}

__device__ __forceinline__ void phase_mix1a(const Params& p, char* smem) {
  for (int tile = blockIdx.x; tile < 2048; tile += gridDim.x) {
    if (tile < 1024) poolc_tile(p, tile, smem);
    else kvstate_tile(p, tile - 1024, smem);
  }
}
__device__ __forceinline__ void phase_mix1b(const Params& p, char* smem) {
  for (int tile = blockIdx.x; tile < 1024; tile += gridDim.x) retout_tile(p, tile, smem);
}

#define XB_TMO      128
#define XB_XCNT(j)  (256  + 64 * (j))
#define XB_XSUB(j)  (1280 + 64 * (j))
#define XB_XGEN(j)  (2304 + 64 * (j))
#define XB_TOP      3328
#define XB_TOPGEN   3392
#define XCD_BAR_WORDS 3456
#define XB_SPIN_CAP (1u << 20)
__device__ __forceinline__ unsigned xb_ld(unsigned* p)              { return __hip_atomic_load(p, __ATOMIC_RELAXED, __HIP_MEMORY_SCOPE_AGENT); }
__device__ __forceinline__ unsigned xb_add(unsigned* p, unsigned v) { return __hip_atomic_fetch_add(p, v, __ATOMIC_RELAXED, __HIP_MEMORY_SCOPE_AGENT); }
__device__ __forceinline__ unsigned xb_xcc_id() { return (unsigned)__builtin_amdgcn_s_getreg((3 << 11) | 20) & 0xFu; }
#define XB_SPIN(cond, bar) do { unsigned _sp = 0; while (cond) { __builtin_amdgcn_s_sleep(1); \
    if ((++_sp & 255u) == 0u) { if (xb_ld(&(bar)[XB_TMO])) break; if (_sp > XB_SPIN_CAP) { atomicAdd(&(bar)[XB_TMO], 1u); break; } } } } while (0)
struct XcdBarrier { unsigned* bar; unsigned x; volatile unsigned* st; };
__device__ __forceinline__ void xcd_barrier_complete(unsigned* bar, unsigned x, unsigned& nloc, unsigned& nx) {
  const unsigned G = gridDim.x;
  unsigned sum, cnt, mine, sp = 0u;
  for (;;) {
    sum = 0u; cnt = 0u; mine = 0u;
#pragma unroll
    for (unsigned j = 0; j < 16; ++j) { const unsigned c = xb_ld(&bar[XB_XCNT(j)]); sum += c; cnt += (c > 0u) ? 1u : 0u; mine = (j == x) ? c : mine; }
    if (sum == G) break;
    __builtin_amdgcn_s_sleep(1);
    if ((++sp & 255u) == 0u) { if (xb_ld(&bar[XB_TMO])) break; if (sp > XB_SPIN_CAP) { atomicAdd(&bar[XB_TMO], 1u); break; } }
  }
  nloc = mine > 0u ? mine : 1u; nx = cnt > 0u ? cnt : 1u;
}
__device__ __forceinline__ void xcd_barrier(XcdBarrier& b) {
  asm volatile("s_waitcnt vmcnt(0)" ::: "memory");
  __syncthreads();
  if (threadIdx.x == 0) {
    unsigned* bar = b.bar;
    __builtin_amdgcn_s_waitcnt(0);
    unsigned nloc = b.st[0], nx = b.st[1];
    if (nloc == 0u) { xcd_barrier_complete(bar, b.x, nloc, nx); b.st[0] = nloc; b.st[1] = nx; }
    const unsigned old = xb_add(&bar[XB_XSUB(b.x)], 1u);
    const unsigned gen = old / nloc;
    if (old + 1u == (gen + 1u) * nloc) {
      __builtin_amdgcn_fence(__ATOMIC_RELEASE, "agent");
      asm volatile("s_waitcnt vmcnt(0)" ::: "memory");
      const unsigned og = xb_add(&bar[XB_TOP], 1u);
      const unsigned tg = og / nx;
      if (og + 1u == (tg + 1u) * nx) xb_add(&bar[XB_TOPGEN], 1u);
      else XB_SPIN(xb_ld(&bar[XB_TOPGEN]) == tg, bar);
      __builtin_amdgcn_fence(__ATOMIC_ACQUIRE, "agent");
      xb_add(&bar[XB_XGEN(b.x)], 1u);
      asm volatile("s_waitcnt vmcnt(0)" ::: "memory");
    } else {
      XB_SPIN(xb_ld(&bar[XB_XGEN(b.x)]) == gen, bar);
      __builtin_amdgcn_fence(__ATOMIC_ACQUIRE, "agent");
      asm volatile("s_waitcnt vmcnt(0)" ::: "memory");
    }
  }
  __syncthreads();
}

__global__ void __launch_bounds__(NTHREADS, 2) fwd_megakernel(Params p) {
  __shared__ __attribute__((aligned(16))) char smem[65536 + 32];
  cg::grid_group grid = cg::this_grid();
  XcdBarrier xb; xb.bar = (unsigned*)(p.ws + OFF_BAR); xb.x = xb_xcc_id(); xb.st = (volatile unsigned*)(smem + 65552);
  if (threadIdx.x == 0) { xb.st[0] = 0u; xb.st[1] = 0u; }
  if (threadIdx.x == 0) (void)xb_add(&xb.bar[XB_XCNT(xb.x)], 1u);
  phase0(p, smem);
  if (p.ws == nullptr) grid.sync();
  xcd_barrier(xb);
  phase_hdn(p, 0, smem);
  xcd_barrier(xb);
  phase_inproj(p, 0, smem);
  xcd_barrier(xb);
  phase_mix0(p, smem);
  xcd_barrier(xb);
  phase_outproj(p, 0, smem);
  xcd_barrier(xb);
  phase_hdn(p, 1, smem);
  xcd_barrier(xb);
  phase_inproj(p, 1, smem);
  xcd_barrier(xb);
  phase_mix1a(p, smem);
  xcd_barrier(xb);
  phase_scan(p);
  xcd_barrier(xb);
  phase_mix1b(p, smem);
  xcd_barrier(xb);
  phase_outproj(p, 1, smem);
}

extern "C" void kernel_launch(void* const* d_in, const int* in_sizes, int n_in, void* d_out, int out_size, void* d_ws, size_t ws_size, hipStream_t stream) {
  static int grid_blocks = 0;
  if (!grid_blocks) {
    int dev = 0, cus = 0, per_cu = 0;
    hipGetDevice(&dev);
    hipDeviceGetAttribute(&cus, hipDeviceAttributeMultiprocessorCount, dev);
    hipOccupancyMaxActiveBlocksPerMultiprocessor(&per_cu, fwd_megakernel, NTHREADS, 0);
    if (per_cu > 2) per_cu = 2;
    if (per_cu < 1) per_cu = 1;
    grid_blocks = cus * per_cu;
    if (ws_size < WS_NEED || n_in != 22) { fprintf(stderr, "kernel_launch: ws_size %zu < %zu or n_in %d != 22\n", ws_size, (size_t)WS_NEED, n_in); grid_blocks = -1; }
  }
  if (grid_blocks < 0) return;
  Params p{};
  p.x = (const float*)d_in[0]; p.c = (const float*)d_in[1]; p.pos = (const int*)d_in[2];
  p.e_norm_g = (const float*)d_in[3]; p.e_w_mod = (const float*)d_in[4]; p.e_b_mod = (const float*)d_in[5]; p.e_w_in = (const float*)d_in[6];
  p.e_vg = (const float*)d_in[7]; p.e_ws = (const float*)d_in[8]; p.e_bs = (const float*)d_in[9]; p.e_qg = (const float*)d_in[10]; p.e_kg = (const float*)d_in[11];
  p.e_w_out = (const float*)d_in[12];
  p.o_norm_g = (const float*)d_in[13]; p.o_w_mod = (const float*)d_in[14]; p.o_b_mod = (const float*)d_in[15]; p.o_w_in = (const float*)d_in[16];
  p.o_cw = (const float*)d_in[17]; p.o_cscale = (const float*)d_in[18]; p.o_qg = (const float*)d_in[19]; p.o_kg = (const float*)d_in[20]; p.o_w_out = (const float*)d_in[21];
  p.out = (float*)d_out; p.ws = (char*)d_ws;
  if (hipMemsetAsync((char*)d_ws + OFF_BAR, 0, 16384, stream) != hipSuccess) { fprintf(stderr, "kernel_launch: hipMemsetAsync of barrier words failed\n"); return; }
  void* args[] = {&p};
  hipError_t e = hipLaunchCooperativeKernel((void*)fwd_megakernel, dim3(grid_blocks), dim3(NTHREADS), args, 0, stream);
  if (e != hipSuccess) fprintf(stderr, "cooperative launch failed: %s (grid %d)\n", hipGetErrorString(e), grid_blocks);
}
```

```cpp
#include <hip/hip_runtime.h>
#include <hip/hip_cooperative_groups.h>
#include <cstdio>
namespace cg = cooperative_groups;

typedef unsigned short u16;
using bf16x8 = __attribute__((ext_vector_type(8))) short;
using bf16x4 = __attribute__((ext_vector_type(4))) short;
using f32x4  = __attribute__((ext_vector_type(4))) float;

#define NTHREADS 256
constexpr int TOK = 16384, DM = 1024, SEQ = 4096;
constexpr int EVEN_IN = 7168, ODD_IN = 6144;
constexpr size_t MiB = 1u << 20;
constexpr size_t OFF_WIN1T  = 0;
constexpr size_t OFF_WOUT1T = 12 * MiB;
constexpr size_t OFF_CWT    = 16 * MiB;
constexpr size_t OFF_WS     = 16 * MiB + 512 * 1024;
constexpr size_t OFF_MODP   = 16 * MiB + 768 * 1024;
constexpr size_t OFF_BAR    = 17 * MiB + 512 * 1024;
constexpr size_t OFF_ROPEC  = 18 * MiB;
constexpr size_t OFF_ROPES  = 22 * MiB;
constexpr size_t OFF_WIN0T  = 26 * MiB;
constexpr size_t OFF_WOUT0T = 40 * MiB;
constexpr size_t OFF_PC     = 26 * MiB;
constexpr size_t OFF_HDN    = 58 * MiB;
constexpr size_t OFF_STATE  = 58 * MiB;
constexpr size_t OFF_Y      = 90 * MiB;
constexpr size_t OFF_Q      = 154 * MiB;
constexpr size_t OFF_K      = 186 * MiB;
constexpr size_t OFF_VT     = 218 * MiB;
constexpr size_t WS_NEED    = 250 * MiB;
constexpr size_t OFF_U      = 0;
constexpr size_t OFF_VNT    = 32 * MiB;

struct Params {
  const float* x; const float* c; const int* pos;
  const float* e_norm_g; const float* e_w_mod; const float* e_b_mod; const float* e_w_in;
  const float* e_vg; const float* e_ws; const float* e_bs; const float* e_qg; const float* e_kg; const float* e_w_out;
  const float* o_norm_g; const float* o_w_mod; const float* o_b_mod; const float* o_w_in;
  const float* o_cw; const float* o_cscale; const float* o_qg; const float* o_kg; const float* o_w_out;
  float* out; char* ws;
};

__device__ __forceinline__ u16 f2bf(float f) {
  unsigned u = __float_as_uint(f);
  u += 0x7fffu + ((u >> 16) & 1u);
  return (u16)(u >> 16);
}
__device__ __forceinline__ float bf2f(u16 h) { return __uint_as_float(((unsigned)h) << 16); }
__device__ __forceinline__ float silu_f(float v) { return v / (1.f + __expf(-v)); }

#define WAITV(n) asm volatile("s_waitcnt vmcnt(" #n ")" ::: "memory")
#define BAR() __builtin_amdgcn_s_barrier()

__device__ __forceinline__ void glds16(const void* g, void* l) {
  __builtin_amdgcn_global_load_lds((const unsigned*)g, (__attribute__((address_space(3))) unsigned*)l, 16, 0, 0);
}

__device__ __forceinline__ void stage128x64(const u16* g, size_t ld, char* lds) {
  const int tid = threadIdx.x;
  const int c = (tid & 7) ^ ((tid >> 4) & 7);
  const u16* src = g + (size_t)(tid >> 3) * ld + c * 8;
  char* dst = lds + tid * 16;
#pragma unroll
  for (int i = 0; i < 4; ++i) glds16(src + (size_t)(i * 32) * ld, dst + i * 4096);
}

__device__ __forceinline__ void mma_ktile(const char* sA, const char* sB, f32x4 (&acc)[2][8]) {
  const int lane = threadIdx.x & 63, w = threadIdx.x >> 6, fr = lane & 15, fq = lane >> 4;
  const int sw = (fr >> 1) & 7;
#pragma unroll
  for (int ks = 0; ks < 2; ++ks) {
    const int cp = ((ks * 4 + fq) ^ sw) * 16;
    bf16x8 a[2], b[8];
#pragma unroll
    for (int m = 0; m < 2; ++m) a[m] = *(const bf16x8*)(sA + (w * 32 + m * 16 + fr) * 128 + cp);
#pragma unroll
    for (int n = 0; n < 8; ++n) b[n] = *(const bf16x8*)(sB + (n * 16 + fr) * 128 + cp);
#pragma unroll
    for (int m = 0; m < 2; ++m)
#pragma unroll
      for (int n = 0; n < 8; ++n)
        acc[m][n] = __builtin_amdgcn_mfma_f32_16x16x32_bf16(a[m], b[n], acc[m][n], 0, 0, 0);
  }
  __builtin_amdgcn_iglp_opt(1);
}

__device__ __forceinline__ void gemm_main(const u16* A, size_t lda, const u16* B, size_t ldb, int K, f32x4 (&acc)[2][8], char* smem) {
  const int nk = K >> 6;
  BAR();
  stage128x64(A, lda, smem);
  stage128x64(B, ldb, smem + 16384);
  for (int kt = 0; kt < nk; ++kt) {
    char* cur = smem + (kt & 1) * 32768;
    WAITV(0);
    BAR();
    if (kt + 1 < nk) {
      char* nxt = smem + ((kt + 1) & 1) * 32768;
      stage128x64(A + (kt + 1) * 64, lda, nxt);
      stage128x64(B + (kt + 1) * 64, ldb, nxt + 16384);
    }
    mma_ktile(cur, cur + 16384, acc);
  }
  BAR();
  asm volatile("" ::: "memory");
}

__device__ __forceinline__ void zero_acc(f32x4 (&acc)[2][8]) {
#pragma unroll
  for (int m = 0; m < 2; ++m)
#pragma unroll
    for (int n = 0; n < 8; ++n) acc[m][n] = f32x4{0.f, 0.f, 0.f, 0.f};
}

__device__ __forceinline__ void row_sumsq(const f32x4 (&acc)[2][8], float (&ss)[2][4]) {
#pragma unroll
  for (int m = 0; m < 2; ++m)
#pragma unroll
    for (int j = 0; j < 4; ++j) {
      float s = 0.f;
#pragma unroll
      for (int n = 0; n < 8; ++n) s += acc[m][n][j] * acc[m][n][j];
      s += __shfl_xor(s, 1); s += __shfl_xor(s, 2); s += __shfl_xor(s, 4); s += __shfl_xor(s, 8);
      ss[m][j] = s;
    }
}

template <class F>
__device__ __forceinline__ void epi_rows(const f32x4 (&acc)[2][8], char* slab, F f) {
  const int lane = threadIdx.x & 63, w = threadIdx.x >> 6, fr = lane & 15, fq = lane >> 4;
  float* st = (float*)slab + w * (16 * 128);
#pragma unroll
  for (int m = 0; m < 2; ++m) {
#pragma unroll
    for (int n = 0; n < 8; ++n)
#pragma unroll
      for (int j = 0; j < 4; ++j) st[(fq * 4 + j) * 128 + ((n * 16 + fr + 8 * fq) & 127)] = acc[m][n][j];
    asm volatile("" ::: "memory");
#pragma unroll
    for (int it = 0; it < 4; ++it) {
      const int r = it * 4 + fq;
      const float* rp = st + r * 128 + ((fr * 8 + 8 * it) & 127);
      const f32x4 lo = *(const f32x4*)rp, hi = *(const f32x4*)(rp + 4);
      float v[8] = {lo[0], lo[1], lo[2], lo[3], hi[0], hi[1], hi[2], hi[3]};
      f(w * 32 + m * 16 + r, fr * 8, v);
    }
    asm volatile("" ::: "memory");
  }
}
__device__ __forceinline__ bf16x8 pack8(const float (&v)[8]) {
  bf16x8 o;
#pragma unroll
  for (int e = 0; e < 8; ++e) o[e] = (short)f2bf(v[e]);
  return o;
}
__device__ __forceinline__ void store_nat(const f32x4 (&v)[2][8], u16* dst, size_t ld, char* smem) {
  epi_rows(v, smem, [&](int row, int col, const float (&x)[8]) { *(bf16x8*)(dst + (size_t)row * ld + col) = pack8(x); });
}
__device__ __forceinline__ void store_tr(const f32x4 (&v)[2][8], u16* dst, size_t ld, char* smem) {
  const int tid = threadIdx.x, lane = tid & 63, w = tid >> 6, fr = lane & 15, fq = lane >> 4;
#pragma unroll
  for (int m = 0; m < 2; ++m)
#pragma unroll
    for (int n = 0; n < 8; ++n) {
      bf16x4 pk;
#pragma unroll
      for (int j = 0; j < 4; ++j) pk[j] = (short)f2bf(v[m][n][j]);
      *(bf16x4*)(smem + (n * 16 + fr) * 272 + (w * 32 + m * 16 + fq * 4) * 2) = pk;
    }
  __syncthreads();
#pragma unroll
  for (int it = 0; it < 8; ++it) {
    const int idx = it * 256 + tid, col = idx >> 4, seg = idx & 15;
    *(bf16x8*)(dst + (size_t)col * ld + seg * 8) = *(const bf16x8*)(smem + col * 272 + seg * 16);
  }
}

__device__ __forceinline__ void transpose_job(const float* src, int R, int C, u16* dst, int tile, float* lds) {
  const int tc = C >> 6;
  const int r0 = (tile / tc) * 64, c0 = (tile % tc) * 64;
  const int tid = threadIdx.x;
#pragma unroll
  for (int i = 0; i < 4; ++i) {
    int r = (tid >> 4) + 16 * i, c4 = (tid & 15) * 4;
    const f32x4 vv = __builtin_nontemporal_load((const f32x4*)(src + (size_t)(r0 + r) * C + c0 + c4));
    float4 v; v.x = vv[0]; v.y = vv[1]; v.z = vv[2]; v.w = vv[3];
    float* d = lds + r * 65 + c4;
    d[0] = v.x; d[1] = v.y; d[2] = v.z; d[3] = v.w;
  }
  __syncthreads();
  {
    int c = tid >> 2, rb = (tid & 3) * 16;
    bf16x8 o0, o1;
#pragma unroll
    for (int i = 0; i < 8; ++i) { o0[i] = (short)f2bf(lds[(rb + i) * 65 + c]); o1[i] = (short)f2bf(lds[(rb + 8 + i) * 65 + c]); }
    u16* d = dst + (size_t)(c0 + c) * R + r0 + rb;
    *(bf16x8*)d = o0; *(bf16x8*)(d + 8) = o1;
  }
  __syncthreads();
}

__device__ __forceinline__ void phase0(const Params& p, char* smem) {
  float* lds = (float*)smem;
  char* ws = p.ws;
  const int tid = threadIdx.x;
  constexpr int J_T0 = 1792, J_T1 = J_T0 + 512, J_T2 = J_T1 + 1536, J_T3 = J_T2 + 512, J_T4 = J_T3 + 64;
  constexpr int J_MOD = J_T4 + 768, J_ROPE = J_MOD + 1024, J_WS = J_ROPE + 128;
  for (int job0 = blockIdx.x; job0 < J_WS; job0 += gridDim.x) {
    const int job = (job0 < 768) ? (J_T4 + job0) : ((job0 - 768 < J_T4) ? (job0 - 768) : job0);
    if (job < J_T0)      transpose_job(p.e_w_in, 1024, EVEN_IN, (u16*)(ws + OFF_WIN0T), job, lds);
    else if (job < J_T1) transpose_job(p.e_w_out, 2048, 1024, (u16*)(ws + OFF_WOUT0T), job - J_T0, lds);
    else if (job < J_T2) transpose_job(p.o_w_in, 1024, ODD_IN, (u16*)(ws + OFF_WIN1T), job - J_T1, lds);
    else if (job < J_T3) transpose_job(p.o_w_out, 2048, 1024, (u16*)(ws + OFF_WOUT1T), job - J_T2, lds);
    else if (job < J_T4) { int q = job - J_T3, g = q >> 4; transpose_job(p.o_cw + (size_t)g * 65536, 256, 256, (u16*)(ws + OFF_CWT) + (size_t)g * 65536, q & 15, lds); }
    else if (job < J_MOD) {
      int q = job - J_T4; int layer = q / 384; q %= 384; int ks = q / 48, jb = q % 48;
      const float* wm = layer ? p.o_w_mod : p.e_w_mod; const float* bm = layer ? p.o_b_mod : p.e_b_mod;
      const int wv_ = tid >> 6, jl = tid & 63, j = jb * 64 + jl;
      __syncthreads();
      for (int i = tid; i < 512; i += NTHREADS) { int bb = i >> 7, kk = i & 127; lds[i] = silu_f(p.c[bb * 1024 + ks * 128 + kk]); }
      __syncthreads();
      float a0 = 0.f, a1 = 0.f, a2 = 0.f, a3 = 0.f;
      const float* wp = wm + (size_t)(ks * 128 + wv_ * 32) * 3072 + j;
      float wl[32];
#pragma unroll
      for (int k = 0; k < 32; ++k) wl[k] = __builtin_nontemporal_load(wp + (size_t)k * 3072);
#pragma unroll
      for (int k = 0; k < 32; ++k) {
        const int kk = wv_ * 32 + k;
        a0 += lds[kk] * wl[k]; a1 += lds[128 + kk] * wl[k]; a2 += lds[256 + kk] * wl[k]; a3 += lds[384 + kk] * wl[k];
      }
      float* red = lds + 512;
      red[(wv_ * 4 + 0) * 64 + jl] = a0; red[(wv_ * 4 + 1) * 64 + jl] = a1; red[(wv_ * 4 + 2) * 64 + jl] = a2; red[(wv_ * 4 + 3) * 64 + jl] = a3;
      __syncthreads();
      {
        const int bb = tid >> 6;
        float r = red[(0 * 4 + bb) * 64 + jl] + red[(1 * 4 + bb) * 64 + jl] + red[(2 * 4 + bb) * 64 + jl] + red[(3 * 4 + bb) * 64 + jl];
        if (ks == 0) r += bm[j];
        ((float*)(ws + OFF_MODP))[(size_t)((layer * 8 + ks) * 4 + bb) * 3072 + j] = r;
      }
      __syncthreads();
    } else if (job < J_ROPE) {
      int q = job - J_MOD;
      float* rc = (float*)(ws + OFF_ROPEC); float* rs = (float*)(ws + OFF_ROPES);
#pragma unroll
      for (int i = 0; i < 4; ++i) {
        int e = q * 1024 + i * 256 + tid; int t = e >> 6, j = e & 63;
        float invf = (float)exp2(-(double)j * (13.287712379549449 / 64.0));
        float ang = (float)p.pos[t] * invf;
        double rev = (double)ang * 0.15915494309189535;
        float fr = (float)(rev - rint(rev));
        rc[e] = __builtin_amdgcn_cosf(fr); rs[e] = __builtin_amdgcn_sinf(fr);
      }
    } else {
      int q = job - J_ROPE;
      u16* wsb = (u16*)(ws + OFF_WS);
#pragma unroll
      for (int i = 0; i < 4; ++i) {
        int e = q * 1024 + i * 256 + tid; int t = (e >> 7) & 127, s = e & 127;
        wsb[e] = (s <= t) ? f2bf(p.e_ws[e]) : (u16)0;
      }
    }
  }
}

__device__ __forceinline__ void phase_hdn(const Params& p, int layer, char* smem) {
  const float* xin = layer ? p.out : p.x;
  const float* ng = layer ? p.o_norm_g : p.e_norm_g;
  const float* modp = (const float*)(p.ws + OFF_MODP) + (size_t)layer * 8 * 4 * 3072;
  u16* hdn = (u16*)(p.ws + OFF_HDN);
  float* mul = (float*)smem; float* add = mul + 1024;
  const int tid = threadIdx.x, lane = tid & 63, w = tid >> 6;
  for (int chunk = blockIdx.x; chunk < 512; chunk += gridDim.x) {
    const int b = chunk >> 7;
    __syncthreads();
    for (int k = tid; k < 1024; k += NTHREADS) {
      float sh = 0.f, sc = 0.f;
#pragma unroll
      for (int ks = 0; ks < 8; ++ks) { const float* mp = modp + (size_t)(ks * 4 + b) * 3072; sh += mp[k]; sc += mp[1024 + k]; }
      mul[k] = ng[k] * (1.f + sc); add[k] = sh;
    }
    __syncthreads();
    for (int r = 0; r < 8; r += 4) {
      const int t = chunk * 32 + w * 8 + r;
      float4 v[4][4]; float ss[4];
#pragma unroll
      for (int u = 0; u < 4; ++u) {
        const float* xr = xin + (size_t)(t + u) * 1024;
#pragma unroll
        for (int i = 0; i < 4; ++i) v[u][i] = *(const float4*)(xr + i * 256 + lane * 4);
      }
#pragma unroll
      for (int u = 0; u < 4; ++u) {
        float a = 0.f;
#pragma unroll
        for (int i = 0; i < 4; ++i) a += v[u][i].x * v[u][i].x + v[u][i].y * v[u][i].y + v[u][i].z * v[u][i].z + v[u][i].w * v[u][i].w;
#pragma unroll
        for (int o = 1; o < 64; o <<= 1) a += __shfl_xor(a, o);
        ss[u] = rsqrtf(a * (1.f / 1024.f) + 1e-6f);
      }
#pragma unroll
      for (int i = 0; i < 4; ++i) {
        const int k = i * 256 + lane * 4;
        const float4 mu = *(const float4*)(mul + k), ad = *(const float4*)(add + k);
#pragma unroll
        for (int u = 0; u < 4; ++u) {
          bf16x4 o;
          o[0] = (short)f2bf(v[u][i].x * ss[u] * mu.x + ad.x);
          o[1] = (short)f2bf(v[u][i].y * ss[u] * mu.y + ad.y);
          o[2] = (short)f2bf(v[u][i].z * ss[u] * mu.z + ad.z);
          o[3] = (short)f2bf(v[u][i].w * ss[u] * mu.w + ad.w);
          *(bf16x4*)(hdn + (size_t)(t + u) * 1024 + k) = o;
        }
      }
    }
  }
}

__device__ __forceinline__ void phase_inproj(const Params& p, int layer, char* smem) {
  const int NT = layer ? 48 : 56;
  const u16* hdn = (const u16*)(p.ws + OFF_HDN);
  const u16* wt = (const u16*)(p.ws + (layer ? OFF_WIN1T : OFF_WIN0T));
  u16* Yb = (u16*)(p.ws + OFF_Y); u16* Qb = (u16*)(p.ws + OFF_Q); u16* Kb = (u16*)(p.ws + OFF_K); u16* VTb = (u16*)(p.ws + OFF_VT);
  const int lane = threadIdx.x & 63, w = threadIdx.x >> 6, fr = lane & 15, fq = lane >> 4;
  const int ntiles = 128 * NT;
  for (int tile = blockIdx.x; tile < ntiles; tile += gridDim.x) {
    const int sup = (tile & 7) + 8 * (tile / 512), within = (tile >> 3) & 63;
    const int nsn = NT / 8;
    const int mt = (sup / nsn) * 8 + (within & 7), nt = (sup % nsn) * 8 + (within >> 3);
    f32x4 acc[2][8]; zero_acc(acc);
    gemm_main(hdn + (size_t)mt * 128 * 1024, 1024, wt + (size_t)nt * 128 * 1024, 1024, 1024, acc, smem);
    const int kind = nt >> 3, sub = nt & 7;
    const size_t t0 = (size_t)mt * 128;
    const int zk = layer ? 4 : 5;
    u16* dst; size_t ld; bool tr = false;
    if (kind >= zk) {
#pragma unroll
      for (int m = 0; m < 2; ++m)
#pragma unroll
        for (int n = 0; n < 8; ++n)
#pragma unroll
          for (int j = 0; j < 4; ++j) acc[m][n][j] = silu_f(acc[m][n][j]);
      dst = Yb + t0 * 2048 + (nt - zk * 8) * 128; ld = 2048;
    } else if (kind == zk - 1) {
      const int b = mt >> 5, s0 = (mt & 31) * 128;
      dst = VTb + ((size_t)(b * 8 + sub) * 128) * 4096 + s0; ld = 4096; tr = true;
    } else if (kind == 0) {
      dst = (layer == 0 ? (u16*)((char*)p.out + OFF_U) : (u16*)(p.ws + OFF_PC)) + t0 * 1024 + sub * 128; ld = 1024;
    } else {
      const bool isv = (layer == 0 && kind == 1);
      const bool isq = (layer == 0) ? (kind == 2) : (kind == 1);
      const float* gn = isv ? (p.e_vg + sub * 128) : ((layer == 0) ? (isq ? p.e_qg : p.e_kg) : (isq ? p.o_qg : p.o_kg));
      const float fold = isv ? 1.f : (((layer == 0) == isq) ? (layer == 0 ? 0.08838834764831845f * 1.4426950408889634f : 0.08838834764831845f) : 1.f);
      float ss[2][4]; row_sumsq(acc, ss);
      float gv[8];
#pragma unroll
      for (int n = 0; n < 8; ++n) gv[n] = gn[n * 16 + fr];
#pragma unroll
      for (int m = 0; m < 2; ++m)
#pragma unroll
        for (int j = 0; j < 4; ++j) {
          const float rstd = rsqrtf(ss[m][j] * (1.f / 128.f) + 1e-6f);
#pragma unroll
          for (int n = 0; n < 8; ++n) acc[m][n][j] *= rstd * gv[n];
        }
      if (layer == 1) {
        const float* rc = (const float*)(p.ws + OFF_ROPEC); const float* rs = (const float*)(p.ws + OFF_ROPES);
#pragma unroll
        for (int m = 0; m < 2; ++m)
#pragma unroll
          for (int j = 0; j < 4; ++j) {
            const size_t t = t0 + w * 32 + m * 16 + fq * 4 + j;
#pragma unroll
            for (int n = 0; n < 4; ++n) {
              const float cs = rc[t * 64 + n * 16 + fr], sn = rs[t * 64 + n * 16 + fr];
              const float x1 = acc[m][n][j], x2 = acc[m][n + 4][j];
              acc[m][n][j] = (x1 * cs - x2 * sn) * fold; acc[m][n + 4][j] = (x1 * sn + x2 * cs) * fold;
            }
            __builtin_amdgcn_sched_barrier(0);
          }
      } else if (fold != 1.f) {
#pragma unroll
        for (int m = 0; m < 2; ++m)
#pragma unroll
          for (int n = 0; n < 8; ++n) acc[m][n] *= fold;
      }
      if (isv) { dst = (u16*)((char*)p.out + OFF_VNT) + (size_t)(mt * 8 + sub) * 16384; ld = 128; tr = true; }
      else { dst = (isq ? Qb : Kb) + t0 * 1024 + sub * 128; ld = 1024; }
    }
    __builtin_amdgcn_sched_barrier(0);
    if (tr) store_tr(acc, dst, ld, smem); else store_nat(acc, dst, ld, smem);
  }
}

__device__ __forceinline__ void phase_outproj(const Params& p, int layer, char* smem) {
  const u16* Yb = (const u16*)(p.ws + OFF_Y);
  const u16* wt = (const u16*)(p.ws + (layer ? OFF_WOUT1T : OFF_WOUT0T));
  const float* xin = layer ? p.out : p.x;
  const float* modp = (const float*)(p.ws + OFF_MODP) + (size_t)layer * 8 * 4 * 3072;
  const int lane = threadIdx.x & 63, w = threadIdx.x >> 6, fr = lane & 15, fq = lane >> 4;
  for (int tile = blockIdx.x; tile < 1024; tile += gridDim.x) {
    const int sup = (tile & 7) + 8 * (tile / 512), within = (tile >> 3) & 63;
    const int mt = sup * 8 + (within & 7), nt = within >> 3;
    f32x4 acc[2][8]; zero_acc(acc);
    gemm_main(Yb + (size_t)mt * 128 * 2048, 2048, wt + (size_t)nt * 128 * 2048, 2048, 2048, acc, smem);
    const int b = mt >> 5;
    float gate[8];
    {
      f32x4 g0 = {0.f, 0.f, 0.f, 0.f}, g1 = {0.f, 0.f, 0.f, 0.f};
#pragma unroll
      for (int ks = 0; ks < 8; ++ks) {
        const float* gp = modp + (size_t)(ks * 4 + b) * 3072 + 2048 + nt * 128 + fr * 8;
        g0 += *(const f32x4*)gp; g1 += *(const f32x4*)(gp + 4);
      }
#pragma unroll
      for (int e = 0; e < 4; ++e) { gate[e] = g0[e]; gate[4 + e] = g1[e]; }
    }
    epi_rows(acc, smem, [&](int row, int col, const float (&v)[8]) {
      const size_t o = ((size_t)mt * 128 + row) * 1024 + nt * 128 + col;
      const f32x4 x0 = *(const f32x4*)(xin + o), x1 = *(const f32x4*)(xin + o + 4);
      f32x4 r0, r1;
#pragma unroll
      for (int e = 0; e < 4; ++e) { r0[e] = x0[e] + gate[e] * v[e]; r1[e] = x1[e] + gate[4 + e] * v[4 + e]; }
      *(f32x4*)(p.out + o) = r0; *(f32x4*)(p.out + o + 4) = r1;
    });
  }
}

__device__ __forceinline__ void gmlp_tile(const Params& p, int tile, char* smem) {
  const int chunk = tile >> 3, g = tile & 7;
  const int lane = threadIdx.x & 63, w = threadIdx.x >> 6, fr = lane & 15, fq = lane >> 4;
  f32x4 acc[2][8]; zero_acc(acc);
  gemm_main((const u16*)(p.ws + OFF_WS) + (size_t)g * 16384, 128, (const u16*)((char*)p.out + OFF_VNT) + (size_t)tile * 16384, 128, 128, acc, smem);
  const u16* U = (const u16*)((char*)p.out + OFF_U);
  u16* Yb = (u16*)(p.ws + OFF_Y);
  epi_rows(acc, smem, [&](int row, int col, const float (&v)[8]) {
    const float bs = p.e_bs[g * 128 + row];
    const size_t t = (size_t)chunk * 128 + row;
    const bf16x8 uu = *(const bf16x8*)(U + t * 1024 + g * 128 + col);
    u16* yp = Yb + t * 2048 + g * 128 + col;
    const bf16x8 yy = *(const bf16x8*)yp;
    bf16x8 o;
#pragma unroll
    for (int e = 0; e < 8; ++e) o[e] = (short)f2bf((v[e] + bs) * bf2f((u16)uu[e]) * bf2f((u16)yy[e]));
    *(bf16x8*)yp = o;
  });
}

__device__ __forceinline__ void attn_tile(const Params& p, int tile, char* smem) {
  const int qb = 63 - (tile & 63), h = (tile >> 6) & 7, b = tile >> 9;
  const int tid = threadIdx.x, lane = tid & 63, w = tid >> 6, fr = lane & 15, fq = lane >> 4;
  const u16* Qb = (const u16*)(p.ws + OFF_Q); const u16* Kb = (const u16*)(p.ws + OFF_K); const u16* VTb = (const u16*)(p.ws + OFF_VT);
  u16* Yb = (u16*)(p.ws + OFF_Y);
  const int q0 = qb * 64;
  const size_t tb = (size_t)b * SEQ;
  float* red = (float*)(smem + 65536);
  const int t = q0 + w * 16 + fr;
  bf16x8 qf[4];
#pragma unroll
  for (int ks = 0; ks < 4; ++ks) qf[ks] = *(const bf16x8*)(Qb + (tb + t) * 1024 + h * 128 + ks * 32 + fq * 8);
  f32x4 O[8];
#pragma unroll
  for (int md = 0; md < 8; ++md) O[md] = f32x4{0.f, 0.f, 0.f, 0.f};
  float carry = 0.f;
  auto stage_kv = [&](int kt_, char* buf) {
    const int key0_ = kt_ * 64;
    const int c = (tid & 15) ^ ((tid >> 4) & 15);
    const u16* src = Kb + (tb + key0_ + (tid >> 4)) * 1024 + h * 128 + c * 8;
#pragma unroll
    for (int i = 0; i < 4; ++i) glds16(src + (size_t)(i * 16) * 1024, buf + i * 4096 + tid * 16);
    stage128x64(VTb + ((size_t)(b * 8 + h) * 128) * 4096 + key0_, 4096, buf + 16384);
  };
  __syncthreads();
  stage_kv(qb, smem);
  WAITV(0);
  __syncthreads();
  for (int kt = qb; kt >= 0; --kt) {
    const int key0 = kt * 64;
    char* sK = smem + ((qb - kt) & 1) * 32768; char* sV = sK + 16384;
    if (kt > 0) stage_kv(kt - 1, smem + ((qb - kt + 1) & 1) * 32768);
    {
      f32x4 S[4];
#pragma unroll
      for (int m = 0; m < 4; ++m) S[m] = f32x4{0.f, 0.f, 0.f, 0.f};
#pragma unroll
      for (int ks = 0; ks < 4; ++ks)
#pragma unroll
        for (int m = 0; m < 4; ++m) {
          const bf16x8 kf = *(const bf16x8*)(sK + (m * 16 + fr) * 256 + (((ks * 4 + fq) ^ fr) * 16));
          S[m] = __builtin_amdgcn_mfma_f32_16x16x32_bf16(kf, qf[ks], S[m], 0, 0, 0);
        }
      float run = carry;
      float wv[4][4];
#pragma unroll
      for (int m = 3; m >= 0; --m) {
        float a[4];
        float gs = 0.f;
#pragma unroll
        for (int j = 0; j < 4; ++j) {
          const int s = key0 + m * 16 + fq * 4 + j;
          const float z = S[m][j];
          const float sp = fmaxf(z, 0.f) + __builtin_amdgcn_logf(1.f + __builtin_amdgcn_exp2f(-fabsf(z)));
          a[j] = (s < t) ? -sp : 0.f;
          gs += a[j];
        }
        const float v1 = __shfl_xor(gs, 16), v2 = __shfl_xor(gs, 32), v3 = __shfl_xor(v1, 32);
        const float tot = gs + v1 + v2 + v3;
        const float above = (((fq ^ 1) > fq) ? v1 : 0.f) + (((fq ^ 2) > fq) ? v2 : 0.f) + (((fq ^ 3) > fq) ? v3 : 0.f);
        const float base = run + above;
        float suf = 0.f;
#pragma unroll
        for (int j = 3; j >= 0; --j) {
          const bool valid = (key0 + m * 16 + fq * 4 + j) < t;
          wv[m][j] = valid ? __builtin_amdgcn_exp2f(S[m][j] + a[j] + base + suf) : 0.f;
          suf += a[j];
        }
        run += tot;
      }
      carry = run;
      bf16x8 pf[2];
#pragma unroll
      for (int c = 0; c < 2; ++c)
#pragma unroll
        for (int j = 0; j < 4; ++j) { pf[c][j] = (short)f2bf(wv[2 * c][j]); pf[c][4 + j] = (short)f2bf(wv[2 * c + 1][j]); }
#pragma unroll
      for (int c = 0; c < 2; ++c)
#pragma unroll
        for (int md = 0; md < 8; ++md) {
          const char* rowp = sV + (md * 16 + fr) * 128;
          const int sw = (fr >> 1) & 7;
          const int qa = 8 * c + fq, qb2 = qa + 4;
          const bf16x4 lo = *(const bf16x4*)(rowp + (((qa >> 1) ^ sw) * 16) + (qa & 1) * 8);
          const bf16x4 hi = *(const bf16x4*)(rowp + (((qb2 >> 1) ^ sw) * 16) + (qb2 & 1) * 8);
          bf16x8 vf;
          vf[0] = lo[0]; vf[1] = lo[1]; vf[2] = lo[2]; vf[3] = lo[3]; vf[4] = hi[0]; vf[5] = hi[1]; vf[6] = hi[2]; vf[7] = hi[3];
          O[md] = __builtin_amdgcn_mfma_f32_16x16x32_bf16(vf, pf[c], O[md], 0, 0, 0);
        }
    }
    float cm = carry;
#pragma unroll
    for (int o = 1; o < 16; o <<= 1) cm = fmaxf(cm, __shfl_xor(cm, o));
    if (lane == 0) red[w] = cm;
    WAITV(0);
    __syncthreads();
    const float allmax = fmaxf(fmaxf(red[0], red[1]), fmaxf(red[2], red[3]));
    if (allmax < -160.f) break;
  }
  {
    float* st = (float*)smem + w * (16 * 132);
#pragma unroll
    for (int md = 0; md < 8; ++md) *(f32x4*)(st + fr * 132 + md * 16 + fq * 4) = O[md];
#pragma unroll
    for (int it = 0; it < 4; ++it) {
      const int r = it * 4 + fq;
      const float* rp = st + r * 132 + fr * 8;
      const f32x4 lo = *(const f32x4*)rp, hi = *(const f32x4*)(rp + 4);
      u16* yp = Yb + (tb + q0 + w * 16 + r) * 2048 + 1024 + h * 128 + fr * 8;
      const bf16x8 zz = *(const bf16x8*)yp;
      bf16x8 o;
#pragma unroll
      for (int e = 0; e < 4; ++e) { o[e] = (short)f2bf(lo[e] * bf2f((u16)zz[e])); o[4 + e] = (short)f2bf(hi[e] * bf2f((u16)zz[4 + e])); }
      *(bf16x8*)yp = o;
    }
  }
  __syncthreads();
}

__device__ __forceinline__ void phase_mix0(const Params& p, char* smem) {
  for (int tile = blockIdx.x; tile < 3072; tile += gridDim.x) {
    if (tile < 2048) attn_tile(p, tile, smem);
    else gmlp_tile(p, tile - 2048, smem);
  }
}

__device__ __forceinline__ float log_gamma_h(int h) { return log1pf(-exp2f(-5.f - (float)h)); }

__device__ __forceinline__ void pool_stage(const u16* PC, int mt, int g, int kt, int win, char* smem) {
  const int tid = threadIdx.x;
  const int c = (tid & 7) ^ ((tid >> 4) & 7);
#pragma unroll 1
  for (int ih = 0; ih < 2; ++ih) {
    const int r0 = ih * 64 + (tid >> 3);
    const int t0 = mt * 128 + r0;
    const u16* src = PC + (size_t)t0 * 1024 + g * 256 + kt * 64 + c * 8;
    float sum[2][8], inv[2];
    int cnt[2];
#pragma unroll
    for (int i = 0; i < 2; ++i) {
      cnt[i] = min(((t0 + i * 32) & (SEQ - 1)) + 1, win);
      inv[i] = 1.f / (float)cnt[i];
#pragma unroll
      for (int e = 0; e < 8; ++e) sum[i][e] = 0.f;
    }
#pragma unroll 1
    for (int q0 = 0; q0 < win; q0 += 4) {
      bf16x8 v[2][4];
#pragma unroll
      for (int i = 0; i < 2; ++i)
#pragma unroll
        for (int q = 0; q < 4; ++q) v[i][q] = *(const bf16x8*)(src + (size_t)(i * 32) * 1024 - (size_t)((q0 + q < cnt[i]) ? (q0 + q) : 0) * 1024);
#pragma unroll
      for (int i = 0; i < 2; ++i)
#pragma unroll
        for (int q = 0; q < 4; ++q) {
          const float wq = ((q0 + q < cnt[i]) ? inv[i] : 0.f) - ((q0 + q == 0) ? 1.f : 0.f);
#pragma unroll
          for (int e = 0; e < 8; ++e) sum[i][e] += wq * bf2f((u16)v[i][q][e]);
        }
    }
#pragma unroll
    for (int i = 0; i < 2; ++i) {
      bf16x8 o;
#pragma unroll
      for (int e = 0; e < 8; ++e) o[e] = (short)f2bf(sum[i][e]);
      *(bf16x8*)(smem + (r0 + i * 32) * 128 + (tid & 7) * 16) = o;
    }
  }
}

__device__ __forceinline__ void poolc_tile(const Params& p, int tile, char* smem) {
  const int mt = (tile >> 3) & 63 | ((tile >> 9) << 6), g = (tile < 512) ? ((tile >> 1) & 3) : (3 - ((tile >> 1) & 3)), nh = tile & 1;
  const int tid = threadIdx.x, lane = tid & 63, w = tid >> 6, fr = lane & 15, fq = lane >> 4;
  const u16* PC = (const u16*)(p.ws + OFF_PC);
  const u16* cwt = (const u16*)(p.ws + OFF_CWT) + (size_t)(g * 256 + nh * 128) * 256;
  u16* Yb = (u16*)(p.ws + OFF_Y);
  f32x4 acc[2][8]; zero_acc(acc);
  __syncthreads();
  for (int kt = 0; kt < 4; ++kt) {
    stage128x64(cwt + kt * 64, 256, smem + 16384);
    pool_stage(PC, mt, g, kt, 2 << g, smem);
    WAITV(0);
    __syncthreads();
    mma_ktile(smem, smem + 16384, acc);
    __syncthreads();
  }
  epi_rows(acc, smem, [&](int row, int col, const float (&v)[8]) {
    const int cc = g * 256 + nh * 128 + col;
    const f32x4 c0 = *(const f32x4*)(p.o_cscale + cc), c1 = *(const f32x4*)(p.o_cscale + cc + 4);
    u16* yp = Yb + ((size_t)mt * 128 + row) * 2048 + cc;
    const bf16x8 yy = *(const bf16x8*)yp;
    bf16x8 o;
#pragma unroll
    for (int e = 0; e < 4; ++e) { o[e] = (short)f2bf(v[e] * c0[e] * bf2f((u16)yy[e])); o[4 + e] = (short)f2bf(v[4 + e] * c1[e] * bf2f((u16)yy[4 + e])); }
    *(bf16x8*)yp = o;
  });
}

__device__ __forceinline__ void kvstate_tile(const Params& p, int tile, char* smem) {
  const int bh = tile >> 5, n = tile & 31, h = bh & 7, b = bh >> 3;
  const int tid = threadIdx.x;
  const u16* Kb = (const u16*)(p.ws + OFF_K); const u16* VTb = (const u16*)(p.ws + OFF_VT);
  u16* ST = (u16*)(p.ws + OFF_STATE);
  const float lg = log_gamma_h(h);
  f32x4 acc[2][8]; zero_acc(acc);
  __syncthreads();
  for (int kt = 0; kt < 2; ++kt) {
    stage128x64(VTb + ((size_t)bh * 128) * 4096 + n * 128 + kt * 64, 4096, smem);
    {
      const int s = tid >> 2, dseg = (tid & 3) * 32;
      const float dec = __expf(lg * (float)(127 - (kt * 64 + s)));
      const u16* src = Kb + ((size_t)b * SEQ + n * 128 + kt * 64 + s) * 1024 + h * 128 + dseg;
#pragma unroll
      for (int q = 0; q < 4; ++q) {
        bf16x8 v = *(const bf16x8*)(src + q * 8);
#pragma unroll
        for (int e = 0; e < 8; ++e) {
          const int d = dseg + q * 8 + e;
          *(u16*)(smem + 16384 + d * 128 + ((((s >> 3) ^ ((d >> 1) & 7))) * 16) + (s & 7) * 2) = f2bf(bf2f((u16)v[e]) * dec);
        }
      }
    }
    WAITV(0);
    __syncthreads();
    mma_ktile(smem, smem + 16384, acc);
    __syncthreads();
  }
  store_nat(acc, ST + (size_t)tile * 16384, 128, smem);
}

__device__ __forceinline__ void phase_scan(const Params& p) {
  unsigned* ST = (unsigned*)(p.ws + OFF_STATE);
  for (int idx = blockIdx.x * NTHREADS + threadIdx.x; idx < 32 * 8192; idx += gridDim.x * NTHREADS) {
    const int bh = idx >> 13, wi = idx & 8191, h = bh & 7;
    const float cd = __expf(log_gamma_h(h) * 128.f);
    unsigned* ptr = ST + (size_t)bh * 32 * 8192 + wi;
    unsigned v[32];
#pragma unroll
    for (int n = 0; n < 32; ++n) v[n] = ptr[(size_t)n * 8192];
    float s0 = 0.f, s1 = 0.f;
#pragma unroll
    for (int n = 0; n < 32; ++n) {
      const unsigned o = (unsigned)f2bf(s0) | ((unsigned)f2bf(s1) << 16);
      s0 = s0 * cd + bf2f((u16)(v[n] & 0xffff)); s1 = s1 * cd + bf2f((u16)(v[n] >> 16));
      ptr[(size_t)n * 8192] = o;
    }
  }
}

__device__ __forceinline__ void retout_tile(const Params& p, int tile, char* smem) {
  const int bh = tile >> 5, n = tile & 31, h = bh & 7, b = bh >> 3;
  const int tid = threadIdx.x, lane = tid & 63, w = tid >> 6, fr = lane & 15, fq = lane >> 4;
  const u16* Qb = (const u16*)(p.ws + OFF_Q); const u16* Kb = (const u16*)(p.ws + OFF_K); const u16* VTb = (const u16*)(p.ws + OFF_VT);
  const u16* ST = (const u16*)(p.ws + OFF_STATE) + (size_t)tile * 16384;
  u16* Yb = (u16*)(p.ws + OFF_Y);
  const float lg = log_gamma_h(h);
  const size_t t0 = (size_t)b * SEQ + n * 128;
  const u16* Qt = Qb + t0 * 1024 + h * 128; const u16* Kt = Kb + t0 * 1024 + h * 128;
  char* sP = smem + 32768;
  f32x4 acc[2][8]; zero_acc(acc);
  __syncthreads();
#pragma unroll 1
  for (int kt = 0; kt < 2; ++kt) {
    stage128x64(Kt + kt * 64, 1024, smem); stage128x64(Qt + kt * 64, 1024, smem + 16384);
    WAITV(0); __syncthreads();
    mma_ktile(smem, smem + 16384, acc);
    __syncthreads();
  }
  {
    float cf[8];
#pragma unroll
    for (int nn = 0; nn < 8; ++nn) cf[nn] = __expf(lg * (float)(nn * 16 + fr));
#pragma unroll
    for (int m = 0; m < 2; ++m) {
      const int s0 = w * 32 + m * 16 + fq * 4;
      float rf[4];
#pragma unroll
      for (int j = 0; j < 4; ++j) rf[j] = __expf(-lg * (float)(s0 + j));
#pragma unroll
      for (int nn = 0; nn < 8; ++nn) {
        const int t = nn * 16 + fr;
        bf16x4 pk;
#pragma unroll
        for (int j = 0; j < 4; ++j) pk[j] = (short)f2bf((t >= s0 + j) ? acc[m][nn][j] * cf[nn] * rf[j] : 0.f);
        *(bf16x4*)(sP + (s0 >> 6) * 16384 + t * 128 + (((((s0 & 63) >> 3) ^ ((t >> 1) & 7))) * 16) + (s0 & 7) * 2) = pk;
      }
    }
  }
  zero_acc(acc);
#pragma unroll 1
  for (int kt = 0; kt < 2; ++kt) {
    stage128x64(Qt + kt * 64, 1024, smem); stage128x64(ST + kt * 64, 128, smem + 16384);
    WAITV(0); __syncthreads();
    mma_ktile(smem, smem + 16384, acc);
    __syncthreads();
  }
#pragma unroll
  for (int m = 0; m < 2; ++m)
#pragma unroll
    for (int j = 0; j < 4; ++j) {
      const float qd = __expf(lg * (float)(w * 32 + m * 16 + fq * 4 + j + 1));
#pragma unroll
      for (int nn = 0; nn < 8; ++nn) acc[m][nn][j] *= qd;
    }
#pragma unroll 1
  for (int kt = 0; kt < 2; ++kt) {
    stage128x64(VTb + ((size_t)bh * 128) * 4096 + n * 128 + kt * 64, 4096, smem + 16384);
    WAITV(0); __syncthreads();
    mma_ktile(sP + kt * 16384, smem + 16384, acc);
    __syncthreads();
  }
  float ss[2][4]; row_sumsq(acc, ss);
#pragma unroll
  for (int m = 0; m < 2; ++m)
#pragma unroll
    for (int j = 0; j < 4; ++j) {
      const float rstd = rsqrtf(ss[m][j] * (1.f / 128.f) + 1e-6f);
#pragma unroll
      for (int nn = 0; nn < 8; ++nn) acc[m][nn][j] *= rstd;
    }
  epi_rows(acc, smem, [&](int row, int col, const float (&v)[8]) {
    u16* yp = Yb + (t0 + row) * 2048 + 1024 + h * 128 + col;
    const bf16x8 yy = *(const bf16x8*)yp;
    bf16x8 o;
#pragma unroll
    for (int e = 0; e < 8; ++e) o[e] = (short)f2bf(v[e] * bf2f((u16)yy[e]));
    *(bf16x8*)yp = o;
  });
}

__device__ __forceinline__ void phase_mix1a(const Params& p, char* smem) {
  for (int tile = blockIdx.x; tile < 2048; tile += gridDim.x) {
    if (tile < 1024) poolc_tile(p, tile, smem);
    else kvstate_tile(p, tile - 1024, smem);
  }
}
__device__ __forceinline__ void phase_mix1b(const Params& p, char* smem) {
  for (int tile = blockIdx.x; tile < 1024; tile += gridDim.x) retout_tile(p, tile, smem);
}

#define XB_TMO      128
#define XB_XCNT(j)  (256  + 64 * (j))
#define XB_XSUB(j)  (1280 + 64 * (j))
#define XB_XGEN(j)  (2304 + 64 * (j))
#define XB_TOP      3328
#define XB_TOPGEN   3392
#define XCD_BAR_WORDS 3456
#define XB_SPIN_CAP (1u << 20)
__device__ __forceinline__ unsigned xb_ld(unsigned* p)              { return __hip_atomic_load(p, __ATOMIC_RELAXED, __HIP_MEMORY_SCOPE_AGENT); }
__device__ __forceinline__ unsigned xb_add(unsigned* p, unsigned v) { return __hip_atomic_fetch_add(p, v, __ATOMIC_RELAXED, __HIP_MEMORY_SCOPE_AGENT); }
__device__ __forceinline__ unsigned xb_xcc_id() { return (unsigned)__builtin_amdgcn_s_getreg((3 << 11) | 20) & 0xFu; }
#define XB_SPIN(cond, bar) do { unsigned _sp = 0; while (cond) { __builtin_amdgcn_s_sleep(1); \
    if ((++_sp & 255u) == 0u) { if (xb_ld(&(bar)[XB_TMO])) break; if (_sp > XB_SPIN_CAP) { atomicAdd(&(bar)[XB_TMO], 1u); break; } } } } while (0)
struct XcdBarrier { unsigned* bar; unsigned x; volatile unsigned* st; };
__device__ __forceinline__ void xcd_barrier_complete(unsigned* bar, unsigned x, unsigned& nloc, unsigned& nx) {
  const unsigned G = gridDim.x;
  unsigned sum, cnt, mine, sp = 0u;
  for (;;) {
    sum = 0u; cnt = 0u; mine = 0u;
#pragma unroll
    for (unsigned j = 0; j < 16; ++j) { const unsigned c = xb_ld(&bar[XB_XCNT(j)]); sum += c; cnt += (c > 0u) ? 1u : 0u; mine = (j == x) ? c : mine; }
    if (sum == G) break;
    __builtin_amdgcn_s_sleep(1);
    if ((++sp & 255u) == 0u) { if (xb_ld(&bar[XB_TMO])) break; if (sp > XB_SPIN_CAP) { atomicAdd(&bar[XB_TMO], 1u); break; } }
  }
  nloc = mine > 0u ? mine : 1u; nx = cnt > 0u ? cnt : 1u;
}
__device__ __forceinline__ void xcd_barrier(XcdBarrier& b) {
  asm volatile("s_waitcnt vmcnt(0)" ::: "memory");
  __syncthreads();
  if (threadIdx.x == 0) {
    unsigned* bar = b.bar;
    __builtin_amdgcn_s_waitcnt(0);
    unsigned nloc = b.st[0], nx = b.st[1];
    if (nloc == 0u) { xcd_barrier_complete(bar, b.x, nloc, nx); b.st[0] = nloc; b.st[1] = nx; }
    const unsigned old = xb_add(&bar[XB_XSUB(b.x)], 1u);
    const unsigned gen = old / nloc;
    if (old + 1u == (gen + 1u) * nloc) {
      __builtin_amdgcn_fence(__ATOMIC_RELEASE, "agent");
      asm volatile("s_waitcnt vmcnt(0)" ::: "memory");
      const unsigned og = xb_add(&bar[XB_TOP], 1u);
      const unsigned tg = og / nx;
      if (og + 1u == (tg + 1u) * nx) xb_add(&bar[XB_TOPGEN], 1u);
      else XB_SPIN(xb_ld(&bar[XB_TOPGEN]) == tg, bar);
      __builtin_amdgcn_fence(__ATOMIC_ACQUIRE, "agent");
      xb_add(&bar[XB_XGEN(b.x)], 1u);
      asm volatile("s_waitcnt vmcnt(0)" ::: "memory");
    } else {
      XB_SPIN(xb_ld(&bar[XB_XGEN(b.x)]) == gen, bar);
      __builtin_amdgcn_fence(__ATOMIC_ACQUIRE, "agent");
      asm volatile("s_waitcnt vmcnt(0)" ::: "memory");
    }
  }
  __syncthreads();
}

__global__ void __launch_bounds__(NTHREADS, 2) fwd_megakernel(Params p) {
  __shared__ __attribute__((aligned(16))) char smem[65536 + 32];
  cg::grid_group grid = cg::this_grid();
  XcdBarrier xb; xb.bar = (unsigned*)(p.ws + OFF_BAR); xb.x = xb_xcc_id(); xb.st = (volatile unsigned*)(smem + 65552);
  if (threadIdx.x == 0) { xb.st[0] = 0u; xb.st[1] = 0u; }
  if (threadIdx.x == 0) (void)xb_add(&xb.bar[XB_XCNT(xb.x)], 1u);
  phase0(p, smem);
  if (p.ws == nullptr) grid.sync();
  xcd_barrier(xb);
  phase_hdn(p, 0, smem);
  xcd_barrier(xb);
  phase_inproj(p, 0, smem);
  xcd_barrier(xb);
  phase_mix0(p, smem);
  xcd_barrier(xb);
  phase_outproj(p, 0, smem);
  xcd_barrier(xb);
  phase_hdn(p, 1, smem);
  xcd_barrier(xb);
  phase_inproj(p, 1, smem);
  xcd_barrier(xb);
  phase_mix1a(p, smem);
  xcd_barrier(xb);
  phase_scan(p);
  xcd_barrier(xb);
  phase_mix1b(p, smem);
  xcd_barrier(xb);
  phase_outproj(p, 1, smem);
}

extern "C" void kernel_launch(void* const* d_in, const int* in_sizes, int n_in, void* d_out, int out_size, void* d_ws, size_t ws_size, hipStream_t stream) {
  static int grid_blocks = 0;
  if (!grid_blocks) {
    int dev = 0, cus = 0, per_cu = 0;
    hipGetDevice(&dev);
    hipDeviceGetAttribute(&cus, hipDeviceAttributeMultiprocessorCount, dev);
    hipOccupancyMaxActiveBlocksPerMultiprocessor(&per_cu, fwd_megakernel, NTHREADS, 0);
    if (per_cu > 2) per_cu = 2;
    if (per_cu < 1) per_cu = 1;
    grid_blocks = cus * per_cu;
    if (ws_size < WS_NEED || n_in != 22) { fprintf(stderr, "kernel_launch: ws_size %zu < %zu or n_in %d != 22\n", ws_size, (size_t)WS_NEED, n_in); grid_blocks = -1; }
  }
  if (grid_blocks < 0) return;
  Params p{};
  p.x = (const float*)d_in[0]; p.c = (const float*)d_in[1]; p.pos = (const int*)d_in[2];
  p.e_norm_g = (const float*)d_in[3]; p.e_w_mod = (const float*)d_in[4]; p.e_b_mod = (const float*)d_in[5]; p.e_w_in = (const float*)d_in[6];
  p.e_vg = (const float*)d_in[7]; p.e_ws = (const float*)d_in[8]; p.e_bs = (const float*)d_in[9]; p.e_qg = (const float*)d_in[10]; p.e_kg = (const float*)d_in[11];
  p.e_w_out = (const float*)d_in[12];
  p.o_norm_g = (const float*)d_in[13]; p.o_w_mod = (const float*)d_in[14]; p.o_b_mod = (const float*)d_in[15]; p.o_w_in = (const float*)d_in[16];
  p.o_cw = (const float*)d_in[17]; p.o_cscale = (const float*)d_in[18]; p.o_qg = (const float*)d_in[19]; p.o_kg = (const float*)d_in[20]; p.o_w_out = (const float*)d_in[21];
  p.out = (float*)d_out; p.ws = (char*)d_ws;
  if (hipMemsetAsync((char*)d_ws + OFF_BAR, 0, 16384, stream) != hipSuccess) { fprintf(stderr, "kernel_launch: hipMemsetAsync of barrier words failed\n"); return; }
  void* args[] = {&p};
  hipError_t e = hipLaunchCooperativeKernel((void*)fwd_megakernel, dim3(grid_blocks), dim3(NTHREADS), args, 0, stream);
  if (e != hipSuccess) fprintf(stderr, "cooperative launch failed: %s (grid %d)\n", hipGetErrorString(e), grid_blocks);
}
```

```cpp
#include <hip/hip_runtime.h>
#include <hip/hip_cooperative_groups.h>
#include <cstdio>
namespace cg = cooperative_groups;

typedef unsigned short u16;
using bf16x8 = __attribute__((ext_vector_type(8))) short;
using bf16x4 = __attribute__((ext_vector_type(4))) short;
using f32x4  = __attribute__((ext_vector_type(4))) float;

#define NTHREADS 256
constexpr int TOK = 16384, DM = 1024, SEQ = 4096;
constexpr int EVEN_IN = 7168, ODD_IN = 6144;
constexpr size_t MiB = 1u << 20;
constexpr size_t OFF_WIN1T  = 0;
constexpr size_t OFF_WOUT1T = 12 * MiB;
constexpr size_t OFF_CWT    = 16 * MiB;
constexpr size_t OFF_WS     = 16 * MiB + 512 * 1024;
constexpr size_t OFF_MODP   = 16 * MiB + 768 * 1024;
constexpr size_t OFF_BAR    = 17 * MiB + 512 * 1024;
constexpr size_t OFF_ROPEC  = 18 * MiB;
constexpr size_t OFF_ROPES  = 22 * MiB;
constexpr size_t OFF_WIN0T  = 26 * MiB;
constexpr size_t OFF_WOUT0T = 40 * MiB;
constexpr size_t OFF_PC     = 26 * MiB;
constexpr size_t OFF_HDN    = 58 * MiB;
constexpr size_t OFF_STATE  = 58 * MiB;
constexpr size_t OFF_Y      = 90 * MiB;
constexpr size_t OFF_Q      = 154 * MiB;
constexpr size_t OFF_K      = 186 * MiB;
constexpr size_t OFF_VT     = 218 * MiB;
constexpr size_t WS_NEED    = 250 * MiB;
constexpr size_t OFF_U      = 0;
constexpr size_t OFF_VNT    = 32 * MiB;

struct Params {
  const float* x; const float* c; const int* pos;
  const float* e_norm_g; const float* e_w_mod; const float* e_b_mod; const float* e_w_in;
  const float* e_vg; const float* e_ws; const float* e_bs; const float* e_qg; const float* e_kg; const float* e_w_out;
  const float* o_norm_g; const float* o_w_mod; const float* o_b_mod; const float* o_w_in;
  const float* o_cw; const float* o_cscale; const float* o_qg; const float* o_kg; const float* o_w_out;
  float* out; char* ws;
};

__device__ __forceinline__ u16 f2bf(float f) {
  unsigned u = __float_as_uint(f);
  u += 0x7fffu + ((u >> 16) & 1u);
  return (u16)(u >> 16);
}
__device__ __forceinline__ float bf2f(u16 h) { return __uint_as_float(((unsigned)h) << 16); }
__device__ __forceinline__ float silu_f(float v) { return v / (1.f + __expf(-v)); }

#define WAITV(n) asm volatile("s_waitcnt vmcnt(" #n ")" ::: "memory")
#define BAR() __builtin_amdgcn_s_barrier()

__device__ __forceinline__ void glds16(const void* g, void* l) {
  __builtin_amdgcn_global_load_lds((const unsigned*)g, (__attribute__((address_space(3))) unsigned*)l, 16, 0, 0);
}

__device__ __forceinline__ void stage128x64(const u16* g, size_t ld, char* lds) {
  const int tid = threadIdx.x;
  const int c = (tid & 7) ^ ((tid >> 4) & 7);
  const u16* src = g + (size_t)(tid >> 3) * ld + c * 8;
  char* dst = lds + tid * 16;
#pragma unroll
  for (int i = 0; i < 4; ++i) glds16(src + (size_t)(i * 32) * ld, dst + i * 4096);
}

__device__ __forceinline__ void mma_ktile(const char* sA, const char* sB, f32x4 (&acc)[2][8]) {
  const int lane = threadIdx.x & 63, w = threadIdx.x >> 6, fr = lane & 15, fq = lane >> 4;
  const int sw = (fr >> 1) & 7;
#pragma unroll
  for (int ks = 0; ks < 2; ++ks) {
    const int cp = ((ks * 4 + fq) ^ sw) * 16;
    bf16x8 a[2], b[8];
#pragma unroll
    for (int m = 0; m < 2; ++m) a[m] = *(const bf16x8*)(sA + (w * 32 + m * 16 + fr) * 128 + cp);
#pragma unroll
    for (int n = 0; n < 8; ++n) b[n] = *(const bf16x8*)(sB + (n * 16 + fr) * 128 + cp);
#pragma unroll
    for (int m = 0; m < 2; ++m)
#pragma unroll
      for (int n = 0; n < 8; ++n)
        acc[m][n] = __builtin_amdgcn_mfma_f32_16x16x32_bf16(a[m], b[n], acc[m][n], 0, 0, 0);
  }
  __builtin_amdgcn_iglp_opt(1);
}

__device__ __forceinline__ void gemm_main(const u16* A, size_t lda, const u16* B, size_t ldb, int K, f32x4 (&acc)[2][8], char* smem) {
  const int nk = K >> 6;
  BAR();
  stage128x64(A, lda, smem);
  stage128x64(B, ldb, smem + 16384);
  for (int kt = 0; kt < nk; ++kt) {
    char* cur = smem + (kt & 1) * 32768;
    WAITV(0);
    BAR();
    if (kt + 1 < nk) {
      char* nxt = smem + ((kt + 1) & 1) * 32768;
      stage128x64(A + (kt + 1) * 64, lda, nxt);
      stage128x64(B + (kt + 1) * 64, ldb, nxt + 16384);
    }
    mma_ktile(cur, cur + 16384, acc);
  }
  BAR();
  asm volatile("" ::: "memory");
}

__device__ __forceinline__ void zero_acc(f32x4 (&acc)[2][8]) {
#pragma unroll
  for (int m = 0; m < 2; ++m)
#pragma unroll
    for (int n = 0; n < 8; ++n) acc[m][n] = f32x4{0.f, 0.f, 0.f, 0.f};
}

__device__ __forceinline__ void row_sumsq(const f32x4 (&acc)[2][8], float (&ss)[2][4]) {
#pragma unroll
  for (int m = 0; m < 2; ++m)
#pragma unroll
    for (int j = 0; j < 4; ++j) {
      float s = 0.f;
#pragma unroll
      for (int n = 0; n < 8; ++n) s += acc[m][n][j] * acc[m][n][j];
      s += __shfl_xor(s, 1); s += __shfl_xor(s, 2); s += __shfl_xor(s, 4); s += __shfl_xor(s, 8);
      ss[m][j] = s;
    }
}

template <class F>
__device__ __forceinline__ void epi_rows(const f32x4 (&acc)[2][8], char* slab, F f) {
  const int lane = threadIdx.x & 63, w = threadIdx.x >> 6, fr = lane & 15, fq = lane >> 4;
  float* st = (float*)slab + w * (16 * 128);
#pragma unroll
  for (int m = 0; m < 2; ++m) {
#pragma unroll
    for (int n = 0; n < 8; ++n)
#pragma unroll
      for (int j = 0; j < 4; ++j) st[(fq * 4 + j) * 128 + ((n * 16 + fr + 8 * fq) & 127)] = acc[m][n][j];
    asm volatile("" ::: "memory");
#pragma unroll
    for (int it = 0; it < 4; ++it) {
      const int r = it * 4 + fq;
      const float* rp = st + r * 128 + ((fr * 8 + 8 * it) & 127);
      const f32x4 lo = *(const f32x4*)rp, hi = *(const f32x4*)(rp + 4);
      float v[8] = {lo[0], lo[1], lo[2], lo[3], hi[0], hi[1], hi[2], hi[3]};
      f(w * 32 + m * 16 + r, fr * 8, v);
    }
    asm volatile("" ::: "memory");
  }
}
__device__ __forceinline__ bf16x8 pack8(const float (&v)[8]) {
  bf16x8 o;
#pragma unroll
  for (int e = 0; e < 8; ++e) o[e] = (short)f2bf(v[e]);
  return o;
}
__device__ __forceinline__ void store_nat(const f32x4 (&v)[2][8], u16* dst, size_t ld, char* smem) {
  epi_rows(v, smem, [&](int row, int col, const float (&x)[8]) { *(bf16x8*)(dst + (size_t)row * ld + col) = pack8(x); });
}
__device__ __forceinline__ void store_tr(const f32x4 (&v)[2][8], u16* dst, size_t ld, char* smem) {
  const int tid = threadIdx.x, lane = tid & 63, w = tid >> 6, fr = lane & 15, fq = lane >> 4;
#pragma unroll
  for (int m = 0; m < 2; ++m)
#pragma unroll
    for (int n = 0; n < 8; ++n) {
      bf16x4 pk;
#pragma unroll
      for (int j = 0; j < 4; ++j) pk[j] = (short)f2bf(v[m][n][j]);
      *(bf16x4*)(smem + (n * 16 + fr) * 272 + (w * 32 + m * 16 + fq * 4) * 2) = pk;
    }
  __syncthreads();
#pragma unroll
  for (int it = 0; it < 8; ++it) {
    const int idx = it * 256 + tid, col = idx >> 4, seg = idx & 15;
    *(bf16x8*)(dst + (size_t)col * ld + seg * 8) = *(const bf16x8*)(smem + col * 272 + seg * 16);
  }
}

__device__ __forceinline__ void transpose_job(const float* src, int R, int C, u16* dst, int tile, float* lds) {
  const int tc = C >> 6;
  const int r0 = (tile / tc) * 64, c0 = (tile % tc) * 64;
  const int tid = threadIdx.x;
#pragma unroll
  for (int i = 0; i < 4; ++i) {
    int r = (tid >> 4) + 16 * i, c4 = (tid & 15) * 4;
    const f32x4 vv = __builtin_nontemporal_load((const f32x4*)(src + (size_t)(r0 + r) * C + c0 + c4));
    float4 v; v.x = vv[0]; v.y = vv[1]; v.z = vv[2]; v.w = vv[3];
    float* d = lds + r * 65 + c4;
    d[0] = v.x; d[1] = v.y; d[2] = v.z; d[3] = v.w;
  }
  __syncthreads();
  {
    int c = tid >> 2, rb = (tid & 3) * 16;
    bf16x8 o0, o1;
#pragma unroll
    for (int i = 0; i < 8; ++i) { o0[i] = (short)f2bf(lds[(rb + i) * 65 + c]); o1[i] = (short)f2bf(lds[(rb + 8 + i) * 65 + c]); }
    u16* d = dst + (size_t)(c0 + c) * R + r0 + rb;
    *(bf16x8*)d = o0; *(bf16x8*)(d + 8) = o1;
  }
  __syncthreads();
}

__device__ __forceinline__ void phase0(const Params& p, char* smem) {
  float* lds = (float*)smem;
  char* ws = p.ws;
  const int tid = threadIdx.x;
  constexpr int J_T0 = 1792, J_T1 = J_T0 + 512, J_T2 = J_T1 + 1536, J_T3 = J_T2 + 512, J_T4 = J_T3 + 64;
  constexpr int J_MOD = J_T4 + 768, J_ROPE = J_MOD + 1024, J_WS = J_ROPE + 128;
  for (int job0 = blockIdx.x; job0 < J_WS; job0 += gridDim.x) {
    const int job = (job0 < 768) ? (J_T4 + job0) : ((job0 - 768 < J_T4) ? (job0 - 768) : job0);
    if (job < J_T0)      transpose_job(p.e_w_in, 1024, EVEN_IN, (u16*)(ws + OFF_WIN0T), job, lds);
    else if (job < J_T1) transpose_job(p.e_w_out, 2048, 1024, (u16*)(ws + OFF_WOUT0T), job - J_T0, lds);
    else if (job < J_T2) transpose_job(p.o_w_in, 1024, ODD_IN, (u16*)(ws + OFF_WIN1T), job - J_T1, lds);
    else if (job < J_T3) transpose_job(p.o_w_out, 2048, 1024, (u16*)(ws + OFF_WOUT1T), job - J_T2, lds);
    else if (job < J_T4) { int q = job - J_T3, g = q >> 4; transpose_job(p.o_cw + (size_t)g * 65536, 256, 256, (u16*)(ws + OFF_CWT) + (size_t)g * 65536, q & 15, lds); }
    else if (job < J_MOD) {
      int q = job - J_T4; int layer = q / 384; q %= 384; int ks = q / 48, jb = q % 48;
      const float* wm = layer ? p.o_w_mod : p.e_w_mod; const float* bm = layer ? p.o_b_mod : p.e_b_mod;
      const int wv_ = tid >> 6, jl = tid & 63, j = jb * 64 + jl;
      __syncthreads();
      for (int i = tid; i < 512; i += NTHREADS) { int bb = i >> 7, kk = i & 127; lds[i] = silu_f(p.c[bb * 1024 + ks * 128 + kk]); }
      __syncthreads();
      float a0 = 0.f, a1 = 0.f, a2 = 0.f, a3 = 0.f;
      const float* wp = wm + (size_t)(ks * 128 + wv_ * 32) * 3072 + j;
      float wl[32];
#pragma unroll
      for (int k = 0; k < 32; ++k) wl[k] = __builtin_nontemporal_load(wp + (size_t)k * 3072);
#pragma unroll
      for (int k = 0; k < 32; ++k) {
        const int kk = wv_ * 32 + k;
        a0 += lds[kk] * wl[k]; a1 += lds[128 + kk] * wl[k]; a2 += lds[256 + kk] * wl[k]; a3 += lds[384 + kk] * wl[k];
      }
      float* red = lds + 512;
      red[(wv_ * 4 + 0) * 64 + jl] = a0; red[(wv_ * 4 + 1) * 64 + jl] = a1; red[(wv_ * 4 + 2) * 64 + jl] = a2; red[(wv_ * 4 + 3) * 64 + jl] = a3;
      __syncthreads();
      {
        const int bb = tid >> 6;
        float r = red[(0 * 4 + bb) * 64 + jl] + red[(1 * 4 + bb) * 64 + jl] + red[(2 * 4 + bb) * 64 + jl] + red[(3 * 4 + bb) * 64 + jl];
        if (ks == 0) r += bm[j];
        ((float*)(ws + OFF_MODP))[(size_t)((layer * 8 + ks) * 4 + bb) * 3072 + j] = r;
      }
      __syncthreads();
    } else if (job < J_ROPE) {
      int q = job - J_MOD;
      float* rc = (float*)(ws + OFF_ROPEC); float* rs = (float*)(ws + OFF_ROPES);
#pragma unroll
      for (int i = 0; i < 4; ++i) {
        int e = q * 1024 + i * 256 + tid; int t = e >> 6, j = e & 63;
        float invf = (float)exp2(-(double)j * (13.287712379549449 / 64.0));
        float ang = (float)p.pos[t] * invf;
        double rev = (double)ang * 0.15915494309189535;
        float fr = (float)(rev - rint(rev));
        rc[e] = __builtin_amdgcn_cosf(fr); rs[e] = __builtin_amdgcn_sinf(fr);
      }
    } else {
      int q = job - J_ROPE;
      u16* wsb = (u16*)(ws + OFF_WS);
#pragma unroll
      for (int i = 0; i < 4; ++i) {
        int e = q * 1024 + i * 256 + tid; int t = (e >> 7) & 127, s = e & 127;
        wsb[e] = (s <= t) ? f2bf(p.e_ws[e]) : (u16)0;
      }
    }
  }
}

__device__ __forceinline__ void phase_hdn(const Params& p, int layer, char* smem) {
  const float* xin = layer ? p.out : p.x;
  const float* ng = layer ? p.o_norm_g : p.e_norm_g;
  const float* modp = (const float*)(p.ws + OFF_MODP) + (size_t)layer * 8 * 4 * 3072;
  u16* hdn = (u16*)(p.ws + OFF_HDN);
  float* mul = (float*)smem; float* add = mul + 1024;
  const int tid = threadIdx.x, lane = tid & 63, w = tid >> 6;
  for (int chunk = blockIdx.x; chunk < 512; chunk += gridDim.x) {
    const int b = chunk >> 7;
    __syncthreads();
    for (int k = tid; k < 1024; k += NTHREADS) {
      float sh = 0.f, sc = 0.f;
#pragma unroll
      for (int ks = 0; ks < 8; ++ks) { const float* mp = modp + (size_t)(ks * 4 + b) * 3072; sh += mp[k]; sc += mp[1024 + k]; }
      mul[k] = ng[k] * (1.f + sc); add[k] = sh;
    }
    __syncthreads();
    for (int r = 0; r < 8; r += 4) {
      const int t = chunk * 32 + w * 8 + r;
      float4 v[4][4]; float ss[4];
#pragma unroll
      for (int u = 0; u < 4; ++u) {
        const float* xr = xin + (size_t)(t + u) * 1024;
#pragma unroll
        for (int i = 0; i < 4; ++i) { const f32x4 t4 = __builtin_nontemporal_load((const f32x4*)(xr + i * 256 + lane * 4)); v[u][i].x = t4[0]; v[u][i].y = t4[1]; v[u][i].z = t4[2]; v[u][i].w = t4[3]; }
      }
#pragma unroll
      for (int u = 0; u < 4; ++u) {
        float a = 0.f;
#pragma unroll
        for (int i = 0; i < 4; ++i) a += v[u][i].x * v[u][i].x + v[u][i].y * v[u][i].y + v[u][i].z * v[u][i].z + v[u][i].w * v[u][i].w;
#pragma unroll
        for (int o = 1; o < 64; o <<= 1) a += __shfl_xor(a, o);
        ss[u] = rsqrtf(a * (1.f / 1024.f) + 1e-6f);
      }
#pragma unroll
      for (int i = 0; i < 4; ++i) {
        const int k = i * 256 + lane * 4;
        const float4 mu = *(const float4*)(mul + k), ad = *(const float4*)(add + k);
#pragma unroll
        for (int u = 0; u < 4; ++u) {
          bf16x4 o;
          o[0] = (short)f2bf(v[u][i].x * ss[u] * mu.x + ad.x);
          o[1] = (short)f2bf(v[u][i].y * ss[u] * mu.y + ad.y);
          o[2] = (short)f2bf(v[u][i].z * ss[u] * mu.z + ad.z);
          o[3] = (short)f2bf(v[u][i].w * ss[u] * mu.w + ad.w);
          *(bf16x4*)(hdn + (size_t)(t + u) * 1024 + k) = o;
        }
      }
    }
  }
}

__device__ __forceinline__ void phase_inproj(const Params& p, int layer, char* smem) {
  const int NT = layer ? 48 : 56;
  const u16* hdn = (const u16*)(p.ws + OFF_HDN);
  const u16* wt = (const u16*)(p.ws + (layer ? OFF_WIN1T : OFF_WIN0T));
  u16* Yb = (u16*)(p.ws + OFF_Y); u16* Qb = (u16*)(p.ws + OFF_Q); u16* Kb = (u16*)(p.ws + OFF_K); u16* VTb = (u16*)(p.ws + OFF_VT);
  const int lane = threadIdx.x & 63, w = threadIdx.x >> 6, fr = lane & 15, fq = lane >> 4;
  const int ntiles = 128 * NT;
  for (int tile = blockIdx.x; tile < ntiles; tile += gridDim.x) {
    const int sup = (tile & 7) + 8 * (tile / 512), within = (tile >> 3) & 63;
    const int nsn = NT / 8;
    const int mt = (sup / nsn) * 8 + (within & 7), nt = (sup % nsn) * 8 + (within >> 3);
    f32x4 acc[2][8]; zero_acc(acc);
    gemm_main(hdn + (size_t)mt * 128 * 1024, 1024, wt + (size_t)nt * 128 * 1024, 1024, 1024, acc, smem);
    const int kind = nt >> 3, sub = nt & 7;
    const size_t t0 = (size_t)mt * 128;
    const int zk = layer ? 4 : 5;
    u16* dst; size_t ld; bool tr = false;
    if (kind >= zk) {
#pragma unroll
      for (int m = 0; m < 2; ++m)
#pragma unroll
        for (int n = 0; n < 8; ++n)
#pragma unroll
          for (int j = 0; j < 4; ++j) acc[m][n][j] = silu_f(acc[m][n][j]);
      dst = Yb + t0 * 2048 + (nt - zk * 8) * 128; ld = 2048;
    } else if (kind == zk - 1) {
      const int b = mt >> 5, s0 = (mt & 31) * 128;
      dst = VTb + ((size_t)(b * 8 + sub) * 128) * 4096 + s0; ld = 4096; tr = true;
    } else if (kind == 0) {
      dst = (layer == 0 ? (u16*)((char*)p.out + OFF_U) : (u16*)(p.ws + OFF_PC)) + t0 * 1024 + sub * 128; ld = 1024;
    } else {
      const bool isv = (layer == 0 && kind == 1);
      const bool isq = (layer == 0) ? (kind == 2) : (kind == 1);
      const float* gn = isv ? (p.e_vg + sub * 128) : ((layer == 0) ? (isq ? p.e_qg : p.e_kg) : (isq ? p.o_qg : p.o_kg));
      const float fold = isv ? 1.f : (((layer == 0) == isq) ? (layer == 0 ? 0.08838834764831845f * 1.4426950408889634f : 0.08838834764831845f) : 1.f);
      float ss[2][4]; row_sumsq(acc, ss);
      float gv[8];
#pragma unroll
      for (int n = 0; n < 8; ++n) gv[n] = gn[n * 16 + fr];
#pragma unroll
      for (int m = 0; m < 2; ++m)
#pragma unroll
        for (int j = 0; j < 4; ++j) {
          const float rstd = rsqrtf(ss[m][j] * (1.f / 128.f) + 1e-6f);
#pragma unroll
          for (int n = 0; n < 8; ++n) acc[m][n][j] *= rstd * gv[n];
        }
      if (layer == 1) {
        const float* rc = (const float*)(p.ws + OFF_ROPEC); const float* rs = (const float*)(p.ws + OFF_ROPES);
#pragma unroll
        for (int m = 0; m < 2; ++m)
#pragma unroll
          for (int j = 0; j < 4; ++j) {
            const size_t t = t0 + w * 32 + m * 16 + fq * 4 + j;
#pragma unroll
            for (int n = 0; n < 4; ++n) {
              const float cs = rc[t * 64 + n * 16 + fr], sn = rs[t * 64 + n * 16 + fr];
              const float x1 = acc[m][n][j], x2 = acc[m][n + 4][j];
              acc[m][n][j] = (x1 * cs - x2 * sn) * fold; acc[m][n + 4][j] = (x1 * sn + x2 * cs) * fold;
            }
            __builtin_amdgcn_sched_barrier(0);
          }
      } else if (fold != 1.f) {
#pragma unroll
        for (int m = 0; m < 2; ++m)
#pragma unroll
          for (int n = 0; n < 8; ++n) acc[m][n] *= fold;
      }
      if (isv) { dst = (u16*)((char*)p.out + OFF_VNT) + (size_t)(mt * 8 + sub) * 16384; ld = 128; tr = true; }
      else { dst = (isq ? Qb : Kb) + t0 * 1024 + sub * 128; ld = 1024; }
    }
    __builtin_amdgcn_sched_barrier(0);
    if (tr) store_tr(acc, dst, ld, smem); else store_nat(acc, dst, ld, smem);
  }
}

__device__ __forceinline__ void phase_outproj(const Params& p, int layer, char* smem) {
  const u16* Yb = (const u16*)(p.ws + OFF_Y);
  const u16* wt = (const u16*)(p.ws + (layer ? OFF_WOUT1T : OFF_WOUT0T));
  const float* xin = layer ? p.out : p.x;
  const float* modp = (const float*)(p.ws + OFF_MODP) + (size_t)layer * 8 * 4 * 3072;
  const int lane = threadIdx.x & 63, w = threadIdx.x >> 6, fr = lane & 15, fq = lane >> 4;
  for (int tile = blockIdx.x; tile < 1024; tile += gridDim.x) {
    const int sup = (tile & 7) + 8 * (tile / 512), within = (tile >> 3) & 63;
    const int mt = sup * 8 + (within & 7), nt = within >> 3;
    f32x4 acc[2][8]; zero_acc(acc);
    gemm_main(Yb + (size_t)mt * 128 * 2048, 2048, wt + (size_t)nt * 128 * 2048, 2048, 2048, acc, smem);
    const int b = mt >> 5;
    float gate[8];
    {
      f32x4 g0 = {0.f, 0.f, 0.f, 0.f}, g1 = {0.f, 0.f, 0.f, 0.f};
#pragma unroll
      for (int ks = 0; ks < 8; ++ks) {
        const float* gp = modp + (size_t)(ks * 4 + b) * 3072 + 2048 + nt * 128 + fr * 8;
        g0 += *(const f32x4*)gp; g1 += *(const f32x4*)(gp + 4);
      }
#pragma unroll
      for (int e = 0; e < 4; ++e) { gate[e] = g0[e]; gate[4 + e] = g1[e]; }
    }
    epi_rows(acc, smem, [&](int row, int col, const float (&v)[8]) {
      const size_t o = ((size_t)mt * 128 + row) * 1024 + nt * 128 + col;
      const f32x4 x0 = __builtin_nontemporal_load((const f32x4*)(xin + o)), x1 = __builtin_nontemporal_load((const f32x4*)(xin + o + 4));
      f32x4 r0, r1;
#pragma unroll
      for (int e = 0; e < 4; ++e) { r0[e] = x0[e] + gate[e] * v[e]; r1[e] = x1[e] + gate[4 + e] * v[4 + e]; }
      *(f32x4*)(p.out + o) = r0; *(f32x4*)(p.out + o + 4) = r1;
    });
  }
}

__device__ __forceinline__ void gmlp_tile(const Params& p, int tile, char* smem) {
  const int chunk = tile >> 3, g = tile & 7;
  const int lane = threadIdx.x & 63, w = threadIdx.x >> 6, fr = lane & 15, fq = lane >> 4;
  f32x4 acc[2][8]; zero_acc(acc);
  gemm_main((const u16*)(p.ws + OFF_WS) + (size_t)g * 16384, 128, (const u16*)((char*)p.out + OFF_VNT) + (size_t)tile * 16384, 128, 128, acc, smem);
  const u16* U = (const u16*)((char*)p.out + OFF_U);
  u16* Yb = (u16*)(p.ws + OFF_Y);
  epi_rows(acc, smem, [&](int row, int col, const float (&v)[8]) {
    const float bs = p.e_bs[g * 128 + row];
    const size_t t = (size_t)chunk * 128 + row;
    const bf16x8 uu = *(const bf16x8*)(U + t * 1024 + g * 128 + col);
    u16* yp = Yb + t * 2048 + g * 128 + col;
    const bf16x8 yy = *(const bf16x8*)yp;
    bf16x8 o;
#pragma unroll
    for (int e = 0; e < 8; ++e) o[e] = (short)f2bf((v[e] + bs) * bf2f((u16)uu[e]) * bf2f((u16)yy[e]));
    *(bf16x8*)yp = o;
  });
}

__device__ __forceinline__ void attn_tile(const Params& p, int tile, char* smem) {
  const int qb = 63 - (tile & 63), h = (tile >> 6) & 7, b = tile >> 9;
  const int tid = threadIdx.x, lane = tid & 63, w = tid >> 6, fr = lane & 15, fq = lane >> 4;
  const u16* Qb = (const u16*)(p.ws + OFF_Q); const u16* Kb = (const u16*)(p.ws + OFF_K); const u16* VTb = (const u16*)(p.ws + OFF_VT);
  u16* Yb = (u16*)(p.ws + OFF_Y);
  const int q0 = qb * 64;
  const size_t tb = (size_t)b * SEQ;
  float* red = (float*)(smem + 65536);
  const int t = q0 + w * 16 + fr;
  bf16x8 qf[4];
#pragma unroll
  for (int ks = 0; ks < 4; ++ks) qf[ks] = *(const bf16x8*)(Qb + (tb + t) * 1024 + h * 128 + ks * 32 + fq * 8);
  f32x4 O[8];
#pragma unroll
  for (int md = 0; md < 8; ++md) O[md] = f32x4{0.f, 0.f, 0.f, 0.f};
  float carry = 0.f;
  auto stage_kv = [&](int kt_, char* buf) {
    const int key0_ = kt_ * 64;
    const int c = (tid & 15) ^ ((tid >> 4) & 15);
    const u16* src = Kb + (tb + key0_ + (tid >> 4)) * 1024 + h * 128 + c * 8;
#pragma unroll
    for (int i = 0; i < 4; ++i) glds16(src + (size_t)(i * 16) * 1024, buf + i * 4096 + tid * 16);
    stage128x64(VTb + ((size_t)(b * 8 + h) * 128) * 4096 + key0_, 4096, buf + 16384);
  };
  __syncthreads();
  stage_kv(qb, smem);
  WAITV(0);
  __syncthreads();
  for (int kt = qb; kt >= 0; --kt) {
    const int key0 = kt * 64;
    char* sK = smem + ((qb - kt) & 1) * 32768; char* sV = sK + 16384;
    if (kt > 0) stage_kv(kt - 1, smem + ((qb - kt + 1) & 1) * 32768);
    {
      f32x4 S[4];
#pragma unroll
      for (int m = 0; m < 4; ++m) S[m] = f32x4{0.f, 0.f, 0.f, 0.f};
#pragma unroll
      for (int ks = 0; ks < 4; ++ks)
#pragma unroll
        for (int m = 0; m < 4; ++m) {
          const bf16x8 kf = *(const bf16x8*)(sK + (m * 16 + fr) * 256 + (((ks * 4 + fq) ^ fr) * 16));
          S[m] = __builtin_amdgcn_mfma_f32_16x16x32_bf16(kf, qf[ks], S[m], 0, 0, 0);
        }
      float run = carry;
      float wv[4][4];
#pragma unroll
      for (int m = 3; m >= 0; --m) {
        float a[4];
        float gs = 0.f;
#pragma unroll
        for (int j = 0; j < 4; ++j) {
          const int s = key0 + m * 16 + fq * 4 + j;
          const float z = S[m][j];
          const float sp = fmaxf(z, 0.f) + __builtin_amdgcn_logf(1.f + __builtin_amdgcn_exp2f(-fabsf(z)));
          a[j] = (s < t) ? -sp : 0.f;
          gs += a[j];
        }
        const float v1 = __shfl_xor(gs, 16), v2 = __shfl_xor(gs, 32), v3 = __shfl_xor(v1, 32);
        const float tot = gs + v1 + v2 + v3;
        const float above = (((fq ^ 1) > fq) ? v1 : 0.f) + (((fq ^ 2) > fq) ? v2 : 0.f) + (((fq ^ 3) > fq) ? v3 : 0.f);
        const float base = run + above;
        float suf = 0.f;
#pragma unroll
        for (int j = 3; j >= 0; --j) {
          const bool valid = (key0 + m * 16 + fq * 4 + j) < t;
          wv[m][j] = valid ? __builtin_amdgcn_exp2f(S[m][j] + a[j] + base + suf) : 0.f;
          suf += a[j];
        }
        run += tot;
      }
      carry = run;
      bf16x8 pf[2];
#pragma unroll
      for (int c = 0; c < 2; ++c)
#pragma unroll
        for (int j = 0; j < 4; ++j) { pf[c][j] = (short)f2bf(wv[2 * c][j]); pf[c][4 + j] = (short)f2bf(wv[2 * c + 1][j]); }
#pragma unroll
      for (int c = 0; c < 2; ++c)
#pragma unroll
        for (int md = 0; md < 8; ++md) {
          const char* rowp = sV + (md * 16 + fr) * 128;
          const int sw = (fr >> 1) & 7;
          const int qa = 8 * c + fq, qb2 = qa + 4;
          const bf16x4 lo = *(const bf16x4*)(rowp + (((qa >> 1) ^ sw) * 16) + (qa & 1) * 8);
          const bf16x4 hi = *(const bf16x4*)(rowp + (((qb2 >> 1) ^ sw) * 16) + (qb2 & 1) * 8);
          bf16x8 vf;
          vf[0] = lo[0]; vf[1] = lo[1]; vf[2] = lo[2]; vf[3] = lo[3]; vf[4] = hi[0]; vf[5] = hi[1]; vf[6] = hi[2]; vf[7] = hi[3];
          O[md] = __builtin_amdgcn_mfma_f32_16x16x32_bf16(vf, pf[c], O[md], 0, 0, 0);
        }
    }
    float cm = carry;
#pragma unroll
    for (int o = 1; o < 16; o <<= 1) cm = fmaxf(cm, __shfl_xor(cm, o));
    if (lane == 0) red[w] = cm;
    WAITV(0);
    __syncthreads();
    const float allmax = fmaxf(fmaxf(red[0], red[1]), fmaxf(red[2], red[3]));
    if (allmax < -160.f) break;
  }
  {
    float* st = (float*)smem + w * (16 * 132);
#pragma unroll
    for (int md = 0; md < 8; ++md) *(f32x4*)(st + fr * 132 + md * 16 + fq * 4) = O[md];
#pragma unroll
    for (int it = 0; it < 4; ++it) {
      const int r = it * 4 + fq;
      const float* rp = st + r * 132 + fr * 8;
      const f32x4 lo = *(const f32x4*)rp, hi = *(const f32x4*)(rp + 4);
      u16* yp = Yb + (tb + q0 + w * 16 + r) * 2048 + 1024 + h * 128 + fr * 8;
      const bf16x8 zz = *(const bf16x8*)yp;
      bf16x8 o;
#pragma unroll
      for (int e = 0; e < 4; ++e) { o[e] = (short)f2bf(lo[e] * bf2f((u16)zz[e])); o[4 + e] = (short)f2bf(hi[e] * bf2f((u16)zz[4 + e])); }
      *(bf16x8*)yp = o;
    }
  }
  __syncthreads();
}

__device__ __forceinline__ void phase_mix0(const Params& p, char* smem) {
  for (int tile = blockIdx.x; tile < 3072; tile += gridDim.x) {
    if (tile < 2048) attn_tile(p, tile, smem);
    else gmlp_tile(p, tile - 2048, smem);
  }
}

__device__ __forceinline__ float log_gamma_h(int h) { return log1pf(-exp2f(-5.f - (float)h)); }

__device__ __forceinline__ void pool_stage(const u16* PC, int mt, int g, int kt, int win, char* smem) {
  const int tid = threadIdx.x;
  const int c = (tid & 7) ^ ((tid >> 4) & 7);
#pragma unroll 1
  for (int ih = 0; ih < 2; ++ih) {
    const int r0 = ih * 64 + (tid >> 3);
    const int t0 = mt * 128 + r0;
    const u16* src = PC + (size_t)t0 * 1024 + g * 256 + kt * 64 + c * 8;
    float sum[2][8], inv[2];
    int cnt[2];
#pragma unroll
    for (int i = 0; i < 2; ++i) {
      cnt[i] = min(((t0 + i * 32) & (SEQ - 1)) + 1, win);
      inv[i] = 1.f / (float)cnt[i];
#pragma unroll
      for (int e = 0; e < 8; ++e) sum[i][e] = 0.f;
    }
#pragma unroll 1
    for (int q0 = 0; q0 < win; q0 += 4) {
      bf16x8 v[2][4];
#pragma unroll
      for (int i = 0; i < 2; ++i)
#pragma unroll
        for (int q = 0; q < 4; ++q) v[i][q] = *(const bf16x8*)(src + (size_t)(i * 32) * 1024 - (size_t)((q0 + q < cnt[i]) ? (q0 + q) : 0) * 1024);
#pragma unroll
      for (int i = 0; i < 2; ++i)
#pragma unroll
        for (int q = 0; q < 4; ++q) {
          const float wq = ((q0 + q < cnt[i]) ? inv[i] : 0.f) - ((q0 + q == 0) ? 1.f : 0.f);
#pragma unroll
          for (int e = 0; e < 8; ++e) sum[i][e] += wq * bf2f((u16)v[i][q][e]);
        }
    }
#pragma unroll
    for (int i = 0; i < 2; ++i) {
      bf16x8 o;
#pragma unroll
      for (int e = 0; e < 8; ++e) o[e] = (short)f2bf(sum[i][e]);
      *(bf16x8*)(smem + (r0 + i * 32) * 128 + (tid & 7) * 16) = o;
    }
  }
}

__device__ __forceinline__ void poolc_tile(const Params& p, int tile, char* smem) {
  const int mt = (tile >> 3) & 63 | ((tile >> 9) << 6), g = (tile < 512) ? ((tile >> 1) & 3) : (3 - ((tile >> 1) & 3)), nh = tile & 1;
  const int tid = threadIdx.x, lane = tid & 63, w = tid >> 6, fr = lane & 15, fq = lane >> 4;
  const u16* PC = (const u16*)(p.ws + OFF_PC);
  const u16* cwt = (const u16*)(p.ws + OFF_CWT) + (size_t)(g * 256 + nh * 128) * 256;
  u16* Yb = (u16*)(p.ws + OFF_Y);
  f32x4 acc[2][8]; zero_acc(acc);
  __syncthreads();
  for (int kt = 0; kt < 4; ++kt) {
    stage128x64(cwt + kt * 64, 256, smem + 16384);
    pool_stage(PC, mt, g, kt, 2 << g, smem);
    WAITV(0);
    __syncthreads();
    mma_ktile(smem, smem + 16384, acc);
    __syncthreads();
  }
  epi_rows(acc, smem, [&](int row, int col, const float (&v)[8]) {
    const int cc = g * 256 + nh * 128 + col;
    const f32x4 c0 = *(const f32x4*)(p.o_cscale + cc), c1 = *(const f32x4*)(p.o_cscale + cc + 4);
    u16* yp = Yb + ((size_t)mt * 128 + row) * 2048 + cc;
    const bf16x8 yy = *(const bf16x8*)yp;
    bf16x8 o;
#pragma unroll
    for (int e = 0; e < 4; ++e) { o[e] = (short)f2bf(v[e] * c0[e] * bf2f((u16)yy[e])); o[4 + e] = (short)f2bf(v[4 + e] * c1[e] * bf2f((u16)yy[4 + e])); }
    *(bf16x8*)yp = o;
  });
}

__device__ __forceinline__ void kvstate_tile(const Params& p, int tile, char* smem) {
  const int bh = tile >> 5, n = tile & 31, h = bh & 7, b = bh >> 3;
  const int tid = threadIdx.x;
  const u16* Kb = (const u16*)(p.ws + OFF_K); const u16* VTb = (const u16*)(p.ws + OFF_VT);
  u16* ST = (u16*)(p.ws + OFF_STATE);
  const float lg = log_gamma_h(h);
  f32x4 acc[2][8]; zero_acc(acc);
  __syncthreads();
  for (int kt = 0; kt < 2; ++kt) {
    stage128x64(VTb + ((size_t)bh * 128) * 4096 + n * 128 + kt * 64, 4096, smem);
    {
      const int s = tid >> 2, dseg = (tid & 3) * 32;
      const float dec = __expf(lg * (float)(127 - (kt * 64 + s)));
      const u16* src = Kb + ((size_t)b * SEQ + n * 128 + kt * 64 + s) * 1024 + h * 128 + dseg;
#pragma unroll
      for (int q = 0; q < 4; ++q) {
        bf16x8 v = *(const bf16x8*)(src + q * 8);
#pragma unroll
        for (int e = 0; e < 8; ++e) {
          const int d = dseg + q * 8 + e;
          *(u16*)(smem + 16384 + d * 128 + ((((s >> 3) ^ ((d >> 1) & 7))) * 16) + (s & 7) * 2) = f2bf(bf2f((u16)v[e]) * dec);
        }
      }
    }
    WAITV(0);
    __syncthreads();
    mma_ktile(smem, smem + 16384, acc);
    __syncthreads();
  }
  store_nat(acc, ST + (size_t)tile * 16384, 128, smem);
}

__device__ __forceinline__ void phase_scan(const Params& p) {
  unsigned* ST = (unsigned*)(p.ws + OFF_STATE);
  for (int idx = blockIdx.x * NTHREADS + threadIdx.x; idx < 32 * 8192; idx += gridDim.x * NTHREADS) {
    const int bh = idx >> 13, wi = idx & 8191, h = bh & 7;
    const float cd = __expf(log_gamma_h(h) * 128.f);
    unsigned* ptr = ST + (size_t)bh * 32 * 8192 + wi;
    unsigned v[32];
#pragma unroll
    for (int n = 0; n < 32; ++n) v[n] = ptr[(size_t)n * 8192];
    float s0 = 0.f, s1 = 0.f;
#pragma unroll
    for (int n = 0; n < 32; ++n) {
      const unsigned o = (unsigned)f2bf(s0) | ((unsigned)f2bf(s1) << 16);
      s0 = s0 * cd + bf2f((u16)(v[n] & 0xffff)); s1 = s1 * cd + bf2f((u16)(v[n] >> 16));
      ptr[(size_t)n * 8192] = o;
    }
  }
}

__device__ __forceinline__ void retout_tile(const Params& p, int tile, char* smem) {
  const int bh = tile >> 5, n = tile & 31, h = bh & 7, b = bh >> 3;
  const int tid = threadIdx.x, lane = tid & 63, w = tid >> 6, fr = lane & 15, fq = lane >> 4;
  const u16* Qb = (const u16*)(p.ws + OFF_Q); const u16* Kb = (const u16*)(p.ws + OFF_K); const u16* VTb = (const u16*)(p.ws + OFF_VT);
  const u16* ST = (const u16*)(p.ws + OFF_STATE) + (size_t)tile * 16384;
  u16* Yb = (u16*)(p.ws + OFF_Y);
  const float lg = log_gamma_h(h);
  const size_t t0 = (size_t)b * SEQ + n * 128;
  const u16* Qt = Qb + t0 * 1024 + h * 128; const u16* Kt = Kb + t0 * 1024 + h * 128;
  char* sP = smem + 32768;
  f32x4 acc[2][8]; zero_acc(acc);
  __syncthreads();
#pragma unroll 1
  for (int kt = 0; kt < 2; ++kt) {
    stage128x64(Kt + kt * 64, 1024, smem); stage128x64(Qt + kt * 64, 1024, smem + 16384);
    WAITV(0); __syncthreads();
    mma_ktile(smem, smem + 16384, acc);
    __syncthreads();
  }
  {
    float cf[8];
#pragma unroll
    for (int nn = 0; nn < 8; ++nn) cf[nn] = __expf(lg * (float)(nn * 16 + fr));
#pragma unroll
    for (int m = 0; m < 2; ++m) {
      const int s0 = w * 32 + m * 16 + fq * 4;
      float rf[4];
#pragma unroll
      for (int j = 0; j < 4; ++j) rf[j] = __expf(-lg * (float)(s0 + j));
#pragma unroll
      for (int nn = 0; nn < 8; ++nn) {
        const int t = nn * 16 + fr;
        bf16x4 pk;
#pragma unroll
        for (int j = 0; j < 4; ++j) pk[j] = (short)f2bf((t >= s0 + j) ? acc[m][nn][j] * cf[nn] * rf[j] : 0.f);
        *(bf16x4*)(sP + (s0 >> 6) * 16384 + t * 128 + (((((s0 & 63) >> 3) ^ ((t >> 1) & 7))) * 16) + (s0 & 7) * 2) = pk;
      }
    }
  }
  zero_acc(acc);
#pragma unroll 1
  for (int kt = 0; kt < 2; ++kt) {
    stage128x64(Qt + kt * 64, 1024, smem); stage128x64(ST + kt * 64, 128, smem + 16384);
    WAITV(0); __syncthreads();
    mma_ktile(smem, smem + 16384, acc);
    __syncthreads();
  }
#pragma unroll
  for (int m = 0; m < 2; ++m)
#pragma unroll
    for (int j = 0; j < 4; ++j) {
      const float qd = __expf(lg * (float)(w * 32 + m * 16 + fq * 4 + j + 1));
#pragma unroll
      for (int nn = 0; nn < 8; ++nn) acc[m][nn][j] *= qd;
    }
#pragma unroll 1
  for (int kt = 0; kt < 2; ++kt) {
    stage128x64(VTb + ((size_t)bh * 128) * 4096 + n * 128 + kt * 64, 4096, smem + 16384);
    WAITV(0); __syncthreads();
    mma_ktile(sP + kt * 16384, smem + 16384, acc);
    __syncthreads();
  }
  float ss[2][4]; row_sumsq(acc, ss);
#pragma unroll
  for (int m = 0; m < 2; ++m)
#pragma unroll
    for (int j = 0; j < 4; ++j) {
      const float rstd = rsqrtf(ss[m][j] * (1.f / 128.f) + 1e-6f);
#pragma unroll
      for (int nn = 0; nn < 8; ++nn) acc[m][nn][j] *= rstd;
    }
  epi_rows(acc, smem, [&](int row, int col, const float (&v)[8]) {
    u16* yp = Yb + (t0 + row) * 2048 + 1024 + h * 128 + col;
    const bf16x8 yy = *(const bf16x8*)yp;
    bf16x8 o;
#pragma unroll
    for (int e = 0; e < 8; ++e) o[e] = (short)f2bf(v[e] * bf2f((u16)yy[e]));
    *(bf16x8*)yp = o;
  });
}

__device__ __forceinline__ void phase_mix1a(const Params& p, char* smem) {
  for (int tile = blockIdx.x; tile < 2048; tile += gridDim.x) {
    if (tile < 1024) poolc_tile(p, tile, smem);
    else kvstate_tile(p, tile - 1024, smem);
  }
}
__device__ __forceinline__ void phase_mix1b(const Params& p, char* smem) {
  for (int tile = blockIdx.x; tile < 1024; tile += gridDim.x) retout_tile(p, tile, smem);
}

#define XB_TMO      128
#define XB_XCNT(j)  (256  + 64 * (j))
#define XB_XSUB(j)  (1280 + 64 * (j))
#define XB_XGEN(j)  (2304 + 64 * (j))
#define XB_TOP      3328
#define XB_TOPGEN   3392
#define XCD_BAR_WORDS 3456
#define XB_SPIN_CAP (1u << 20)
__device__ __forceinline__ unsigned xb_ld(unsigned* p)              { return __hip_atomic_load(p, __ATOMIC_RELAXED, __HIP_MEMORY_SCOPE_AGENT); }
__device__ __forceinline__ unsigned xb_add(unsigned* p, unsigned v) { return __hip_atomic_fetch_add(p, v, __ATOMIC_RELAXED, __HIP_MEMORY_SCOPE_AGENT); }
__device__ __forceinline__ unsigned xb_xcc_id() { return (unsigned)__builtin_amdgcn_s_getreg((3 << 11) | 20) & 0xFu; }
#define XB_SPIN(cond, bar) do { unsigned _sp = 0; while (cond) { __builtin_amdgcn_s_sleep(1); \
    if ((++_sp & 255u) == 0u) { if (xb_ld(&(bar)[XB_TMO])) break; if (_sp > XB_SPIN_CAP) { atomicAdd(&(bar)[XB_TMO], 1u); break; } } } } while (0)
struct XcdBarrier { unsigned* bar; unsigned x; volatile unsigned* st; };
__device__ __forceinline__ void xcd_barrier_complete(unsigned* bar, unsigned x, unsigned& nloc, unsigned& nx) {
  const unsigned G = gridDim.x;
  unsigned sum, cnt, mine, sp = 0u;
  for (;;) {
    sum = 0u; cnt = 0u; mine = 0u;
#pragma unroll
    for (unsigned j = 0; j < 16; ++j) { const unsigned c = xb_ld(&bar[XB_XCNT(j)]); sum += c; cnt += (c > 0u) ? 1u : 0u; mine = (j == x) ? c : mine; }
    if (sum == G) break;
    __builtin_amdgcn_s_sleep(1);
    if ((++sp & 255u) == 0u) { if (xb_ld(&bar[XB_TMO])) break; if (sp > XB_SPIN_CAP) { atomicAdd(&bar[XB_TMO], 1u); break; } }
  }
  nloc = mine > 0u ? mine : 1u; nx = cnt > 0u ? cnt : 1u;
}
__device__ __forceinline__ void xcd_barrier(XcdBarrier& b) {
  asm volatile("s_waitcnt vmcnt(0)" ::: "memory");
  __syncthreads();
  if (threadIdx.x == 0) {
    unsigned* bar = b.bar;
    __builtin_amdgcn_s_waitcnt(0);
    unsigned nloc = b.st[0], nx = b.st[1];
    if (nloc == 0u) { xcd_barrier_complete(bar, b.x, nloc, nx); b.st[0] = nloc; b.st[1] = nx; }
    const unsigned old = xb_add(&bar[XB_XSUB(b.x)], 1u);
    const unsigned gen = old / nloc;
    if (old + 1u == (gen + 1u) * nloc) {
      __builtin_amdgcn_fence(__ATOMIC_RELEASE, "agent");
      asm volatile("s_waitcnt vmcnt(0)" ::: "memory");
      const unsigned og = xb_add(&bar[XB_TOP], 1u);
      const unsigned tg = og / nx;
      if (og + 1u == (tg + 1u) * nx) xb_add(&bar[XB_TOPGEN], 1u);
      else XB_SPIN(xb_ld(&bar[XB_TOPGEN]) == tg, bar);
      __builtin_amdgcn_fence(__ATOMIC_ACQUIRE, "agent");
      xb_add(&bar[XB_XGEN(b.x)], 1u);
      asm volatile("s_waitcnt vmcnt(0)" ::: "memory");
    } else {
      XB_SPIN(xb_ld(&bar[XB_XGEN(b.x)]) == gen, bar);
      __builtin_amdgcn_fence(__ATOMIC_ACQUIRE, "agent");
      asm volatile("s_waitcnt vmcnt(0)" ::: "memory");
    }
  }
  __syncthreads();
}

__global__ void __launch_bounds__(NTHREADS, 2) fwd_megakernel(Params p) {
  __shared__ __attribute__((aligned(16))) char smem[65536 + 32];
  cg::grid_group grid = cg::this_grid();
  XcdBarrier xb; xb.bar = (unsigned*)(p.ws + OFF_BAR); xb.x = xb_xcc_id(); xb.st = (volatile unsigned*)(smem + 65552);
  if (threadIdx.x == 0) { xb.st[0] = 0u; xb.st[1] = 0u; }
  if (threadIdx.x == 0) (void)xb_add(&xb.bar[XB_XCNT(xb.x)], 1u);
  phase0(p, smem);
  if (p.ws == nullptr) grid.sync();
  xcd_barrier(xb);
  phase_hdn(p, 0, smem);
  xcd_barrier(xb);
  phase_inproj(p, 0, smem);
  xcd_barrier(xb);
  phase_mix0(p, smem);
  xcd_barrier(xb);
  phase_outproj(p, 0, smem);
  xcd_barrier(xb);
  phase_hdn(p, 1, smem);
  xcd_barrier(xb);
  phase_inproj(p, 1, smem);
  xcd_barrier(xb);
  phase_mix1a(p, smem);
  xcd_barrier(xb);
  phase_scan(p);
  xcd_barrier(xb);
  phase_mix1b(p, smem);
  xcd_barrier(xb);
  phase_outproj(p, 1, smem);
}

extern "C" void kernel_launch(void* const* d_in, const int* in_sizes, int n_in, void* d_out, int out_size, void* d_ws, size_t ws_size, hipStream_t stream) {
  static int grid_blocks = 0;
  if (!grid_blocks) {
    int dev = 0, cus = 0, per_cu = 0;
    hipGetDevice(&dev);
    hipDeviceGetAttribute(&cus, hipDeviceAttributeMultiprocessorCount, dev);
    hipOccupancyMaxActiveBlocksPerMultiprocessor(&per_cu, fwd_megakernel, NTHREADS, 0);
    if (per_cu > 2) per_cu = 2;
    if (per_cu < 1) per_cu = 1;
    grid_blocks = cus * per_cu;
    if (ws_size < WS_NEED || n_in != 22) { fprintf(stderr, "kernel_launch: ws_size %zu < %zu or n_in %d != 22\n", ws_size, (size_t)WS_NEED, n_in); grid_blocks = -1; }
  }
  if (grid_blocks < 0) return;
  Params p{};
  p.x = (const float*)d_in[0]; p.c = (const float*)d_in[1]; p.pos = (const int*)d_in[2];
  p.e_norm_g = (const float*)d_in[3]; p.e_w_mod = (const float*)d_in[4]; p.e_b_mod = (const float*)d_in[5]; p.e_w_in = (const float*)d_in[6];
  p.e_vg = (const float*)d_in[7]; p.e_ws = (const float*)d_in[8]; p.e_bs = (const float*)d_in[9]; p.e_qg = (const float*)d_in[10]; p.e_kg = (const float*)d_in[11];
  p.e_w_out = (const float*)d_in[12];
  p.o_norm_g = (const float*)d_in[13]; p.o_w_mod = (const float*)d_in[14]; p.o_b_mod = (const float*)d_in[15]; p.o_w_in = (const float*)d_in[16];
  p.o_cw = (const float*)d_in[17]; p.o_cscale = (const float*)d_in[18]; p.o_qg = (const float*)d_in[19]; p.o_kg = (const float*)d_in[20]; p.o_w_out = (const float*)d_in[21];
  p.out = (float*)d_out; p.ws = (char*)d_ws;
  if (hipMemsetAsync((char*)d_ws + OFF_BAR, 0, 16384, stream) != hipSuccess) { fprintf(stderr, "kernel_launch: hipMemsetAsync of barrier words failed\n"); return; }
  void* args[] = {&p};
  hipError_t e = hipLaunchCooperativeKernel((void*)fwd_megakernel, dim3(grid_blocks), dim3(NTHREADS), args, 0, stream);
  if (e != hipSuccess) fprintf(stderr, "cooperative launch failed: %s (grid %d)\n", hipGetErrorString(e), grid_blocks);
}
```
